# Optimizing an MI355X kernel written in HIP

```python
import jax, jax.numpy as jnp
from jax import lax
import numpy as np

D_MODEL = 1024
BATCH = 8
SEQ = 4096
DEPTH = 4

GRID_W = 64
CTX_LEN = 256
D_FF = 2752
N_MOD = 9
EPS = 1e-6
D_FOURIER = D_MODEL // 2
FOURIER_CH = 128
FOURIER_GROUPS = D_FOURIER // FOURIER_CH
D_SGU = D_MODEL // 2
SGU_CH = 128
SGU_GROUPS = D_SGU // SGU_CH
CHUNK = 128
HEAD_DIM = 128
N_HEADS = D_MODEL // HEAD_DIM
N_KV_HEADS = 2
GROUP = N_HEADS // N_KV_HEADS
ROPE_AXIS_DIM = HEAD_DIM // 2
ROPE_THETA = 10000.0
Q_BLOCK = 128

kernel_name = "hybrid_fnet_gmlp_gqa_dit_prefix"


def rms_norm(x, g):
    xf = x.astype(jnp.float32)
    y = xf * lax.rsqrt(jnp.mean(jnp.square(xf), axis=-1, keepdims=True) + EPS)
    return (y * g.astype(jnp.float32)).astype(x.dtype)


def adaln(cvec, w_mod, b_mod):
    m = jax.nn.silu(cvec) @ w_mod + b_mod
    m = m.reshape(m.shape[0], 1, N_MOD, D_MODEL)
    return [m[:, :, i] for i in range(N_MOD)]


def modulated_norm(x, g, shift, scale):
    return rms_norm(x, g) * (1 + scale) + shift


def swiglu(h, w_gu, w_down):
    gate, up = jnp.split(h @ w_gu, 2, axis=-1)
    return (jax.nn.silu(gate) * up) @ w_down


def ffn_half_step(x, mods, g, w_gu, w_down):
    shift, scale, gate = mods
    return x + 0.5 * gate * swiglu(modulated_norm(x, g, shift, scale), w_gu, w_down)


def fourier_mix(a):
    b_, n, _ = a.shape
    a4 = a.reshape(b_, n, FOURIER_GROUPS, FOURIER_CH).astype(jnp.float32)
    f = jnp.fft.fftn(a4, axes=(1, 3), norm="ortho").real
    return f.reshape(b_, n, D_FOURIER).astype(a.dtype)


def chunk_sgu(u, v, g_v, w_s, b_s):
    b_, n, _ = v.shape
    vh = rms_norm(v.reshape(b_, n, SGU_GROUPS, SGU_CH), g_v)
    vc = vh.reshape(b_, n // CHUNK, CHUNK, SGU_GROUPS, SGU_CH)
    mixed = jnp.einsum('hpq,bcqhd->bcphd', w_s, vc) + b_s.T[None, None, :, :, None]
    return u * mixed.reshape(b_, n, D_SGU)


def fourier_sgu_mixer(h, w_in, g_v, w_s, b_s, w_out):
    a, uv = jnp.split(h @ w_in, [D_FOURIER], axis=-1)
    u, v = jnp.split(jax.nn.gelu(uv), 2, axis=-1)
    out = jnp.concatenate([fourier_mix(a), chunk_sgu(u, v, g_v, w_s, b_s)], axis=-1)
    return out @ w_out


def axial_angles(rows):
    row = jnp.repeat(jnp.arange(rows, dtype=jnp.float32), GRID_W)
    col = jnp.tile(jnp.arange(GRID_W, dtype=jnp.float32), rows)
    inv_freq = ROPE_THETA ** (-jnp.arange(0, ROPE_AXIS_DIM, 2, dtype=jnp.float32) / ROPE_AXIS_DIM)
    return row[:, None] * inv_freq, col[:, None] * inv_freq


def rotate(x, ang):
    full = jnp.concatenate([ang, ang], axis=-1)[:, None, :]
    cos = jnp.cos(full).astype(x.dtype)
    sin = jnp.sin(full).astype(x.dtype)
    x1, x2 = jnp.split(x, 2, axis=-1)
    return x * cos + jnp.concatenate([-x2, x1], axis=-1) * sin


def axial_rope(x, ang_row, ang_col):
    xr, xc = jnp.split(x, 2, axis=-1)
    return jnp.concatenate([rotate(xr, ang_row), rotate(xc, ang_col)], axis=-1)


def project_kv(kv, g_k):
    b_, n, _ = kv.shape
    k, v = jnp.split(kv, 2, axis=-1)
    k = rms_norm(k.reshape(b_, n, N_KV_HEADS, HEAD_DIM), g_k)
    return k, v.reshape(b_, n, N_KV_HEADS, HEAD_DIM)


def project_q(q, g_q):
    b_, n, _ = q.shape
    return rms_norm(q.reshape(b_, n, N_HEADS, HEAD_DIM), g_q)


def gqa_attend(q, k, v):
    b_, nq = q.shape[:2]
    qg = q.reshape(b_, nq, N_KV_HEADS, GROUP, HEAD_DIM)
    s = jnp.einsum('bqkgd,bskd->bkgqs', qg, k, preferred_element_type=jnp.float32) * (HEAD_DIM ** -0.5)
    p = jax.nn.softmax(s, axis=-1).astype(v.dtype)
    o = jnp.einsum('bkgqs,bskd->bqkgd', p, v)
    return o.reshape(b_, nq, N_HEADS * HEAD_DIM)


def blocked_attention(q, k_all, v_all):
    b_, n = q.shape[:2]
    n_blk = n // Q_BLOCK
    qb = jnp.moveaxis(q.reshape(b_, n_blk, Q_BLOCK, N_HEADS, HEAD_DIM), 1, 0)
    o = lax.map(lambda qblk: gqa_attend(qblk, k_all, v_all), qb)
    return jnp.moveaxis(o, 0, 1).reshape(b_, n, N_HEADS * HEAD_DIM)


def setup_inputs(seed: int = 0) -> dict:
    key = jax.random.key(seed)
    ks = jax.random.split(key, 24)
    n_even = (DEPTH + 1) // 2
    n_odd = DEPTH // 2

    def nrm(k, shape, fan_in, s=1.0):
        return s * jax.random.normal(k, shape, jnp.float32) * (fan_in ** -0.5)

    def gain(k, shape):
        return 1.0 + 0.05 * jax.random.normal(k, shape, jnp.float32)

    return {
        "x": jax.random.normal(ks[0], (BATCH, SEQ, D_MODEL), jnp.float32),
        "c": jax.random.normal(ks[1], (BATCH, D_MODEL), jnp.float32),
        "ctx": jax.random.normal(ks[2], (BATCH, CTX_LEN, D_MODEL), jnp.float32),
        "c_ctx": jax.random.normal(ks[3], (D_MODEL,), jnp.float32),
        "w_mod": nrm(ks[4], (DEPTH, D_MODEL, N_MOD * D_MODEL), D_MODEL, 0.5),
        "b_mod": 0.02 * jax.random.normal(ks[5], (DEPTH, N_MOD * D_MODEL), jnp.float32),
        "g_ffn1": gain(ks[6], (DEPTH, D_MODEL)),
        "w_ffn1_gu": nrm(ks[7], (DEPTH, D_MODEL, 2 * D_FF), D_MODEL),
        "w_ffn1_down": nrm(ks[8], (DEPTH, D_FF, D_MODEL), D_FF),
        "g_mix": gain(ks[9], (DEPTH, D_MODEL)),
        "g_ffn2": gain(ks[10], (DEPTH, D_MODEL)),
        "w_ffn2_gu": nrm(ks[11], (DEPTH, D_MODEL, 2 * D_FF), D_MODEL),
        "w_ffn2_down": nrm(ks[12], (DEPTH, D_FF, D_MODEL), D_FF),
        "g_final": gain(ks[13], (D_MODEL,)),
        "w_in_ab": nrm(ks[14], (n_even, D_MODEL, D_FOURIER + 2 * D_SGU), D_MODEL),
        "g_v": gain(ks[15], (n_even, SGU_GROUPS, SGU_CH)),
        "w_s": nrm(ks[16], (n_even, SGU_GROUPS, CHUNK, CHUNK), CHUNK, 0.5),
        "b_s": 1.0 + 0.02 * jax.random.normal(ks[17], (n_even, SGU_GROUPS, CHUNK), jnp.float32),
        "w_out_ab": nrm(ks[18], (n_even, D_FOURIER + D_SGU, D_MODEL), D_FOURIER + D_SGU),
        "w_qkv": nrm(ks[19], (n_odd, D_MODEL, (N_HEADS + 2 * N_KV_HEADS) * HEAD_DIM), D_MODEL),
        "g_q": gain(ks[20], (n_odd, HEAD_DIM)),
        "g_k": gain(ks[21], (n_odd, HEAD_DIM)),
        "w_o": nrm(ks[22], (n_odd, N_HEADS * HEAD_DIM, D_MODEL), N_HEADS * HEAD_DIM),
    }


def reference(x, c, ctx, c_ctx, w_mod, b_mod, g_ffn1, w_ffn1_gu, w_ffn1_down, g_mix,
              g_ffn2, w_ffn2_gu, w_ffn2_down, g_final, w_in_ab, g_v, w_s, b_s, w_out_ab,
              w_qkv, g_q, g_k, w_o):
    n_tok = x.shape[1]
    ROWS = n_tok // GRID_W
    ang_row, ang_col = axial_angles(ROWS)
    q_cols = N_HEADS * HEAD_DIM

    for l in range(DEPTH):
        last = l == DEPTH - 1
        even = l % 2 == 0
        j = l // 2
        mx = adaln(c, w_mod[l], b_mod[l])
        mc = adaln(c_ctx[None], w_mod[l], b_mod[l])
        ctx_live = (not last) or (not even)

        x = ffn_half_step(x, mx[0:3], g_ffn1[l], w_ffn1_gu[l], w_ffn1_down[l])
        if ctx_live:
            ctx = ffn_half_step(ctx, mc[0:3], g_ffn1[l], w_ffn1_gu[l], w_ffn1_down[l])

        hx = modulated_norm(x, g_mix[l], mx[3], mx[4])
        if even:
            out_x = fourier_sgu_mixer(hx, w_in_ab[j], g_v[j], w_s[j], b_s[j], w_out_ab[j])
            if not last:
                hc = modulated_norm(ctx, g_mix[l], mc[3], mc[4])
                out_c = fourier_sgu_mixer(hc, w_in_ab[j], g_v[j], w_s[j], b_s[j], w_out_ab[j])
        else:
            hc = modulated_norm(ctx, g_mix[l], mc[3], mc[4])
            qkv_x = hx @ w_qkv[j]
            q_x = axial_rope(project_q(qkv_x[..., :q_cols], g_q[j]), ang_row, ang_col)
            k_x, v_x = project_kv(qkv_x[..., q_cols:], g_k[j])
            k_x = axial_rope(k_x, ang_row, ang_col)
            if last:
                k_c, v_c = project_kv(hc @ w_qkv[j][:, q_cols:], g_k[j])
            else:
                qkv_c = hc @ w_qkv[j]
                k_c, v_c = project_kv(qkv_c[..., q_cols:], g_k[j])
                q_c = project_q(qkv_c[..., :q_cols], g_q[j])
                out_c = gqa_attend(q_c, k_c, v_c) @ w_o[j]
            k_all = jnp.concatenate([k_x, k_c], axis=1)
            v_all = jnp.concatenate([v_x, v_c], axis=1)
            out_x = blocked_attention(q_x, k_all, v_all) @ w_o[j]

        x = x + mx[5] * out_x
        x = ffn_half_step(x, mx[6:9], g_ffn2[l], w_ffn2_gu[l], w_ffn2_down[l])
        if not last:
            ctx = ctx + mc[5] * out_c
            ctx = ffn_half_step(ctx, mc[6:9], g_ffn2[l], w_ffn2_gu[l], w_ffn2_down[l])

    return rms_norm(x, g_final)
```

```cpp
#include <hip/hip_runtime.h>
#include <hip/hip_bf16.h>
#include <hip/hip_cooperative_groups.h>
#include <cstdio>
#include <cstdint>
#include <cmath>
namespace cg = cooperative_groups;
__device__ __forceinline__ int opaque_tid() { int t = (int)threadIdx.x; asm volatile("" : "+v"(t)); return t; }
#define LAS __attribute__((address_space(3)))
__device__ __forceinline__ int opaque_G() { int g = (int)gridDim.x; asm volatile("" : "+s"(g)); return g; }
namespace pg8 {
#define PG8_LAS __attribute__((address_space(3)))
typedef unsigned short bf16_t;
typedef short bf16x8 __attribute__((ext_vector_type(8)));
typedef float f32x4 __attribute__((ext_vector_type(4)));
typedef unsigned u32x4 __attribute__((ext_vector_type(4)));
constexpr int BM = 256, BK = 64, HALF = 128, HTB = HALF * BK * 2  , STAGE_BYTES = 8 * HTB, NXCD = 8, WGM = 4;

__host__ __device__ __forceinline__ int lds_byte(int r, int c) { const int st = (r >> 4) * 2 + (c >> 5), rr = r & 15, cc = c & 31, ob = rr * 64 + cc * 2; return st * 1024 + (ob ^ (((ob >> 9) & 1) << 5)); }
__host__ __device__ __forceinline__ void stage_rc(int b, int& R, int& C) { const int st = b / 1024, sb = b % 1024, swz = sb ^ (((sb >> 9) & 1) << 5); R = (st >> 1) * 16 + swz / 64; C = (st & 1) * 32 + (swz % 64) / 2; }
__host__ __device__ __forceinline__ int perm32(int rho) { const int n = rho >> 4, i = rho & 15; return 8 * (i >> 2) + 4 * n + (i & 3); }

struct Unit { int pm, pn; };
struct Gemm { const bf16_t* A; const bf16_t* Bt; int M, N, K, ld; };

struct StaticOrder {
    int nM, nN, nwg, G, c;
    __host__ __device__ void init(int M, int N, int G_, int c_) { nM = M / BM; nN = N / BM; nwg = nM * nN; G = G_; c = c_; }
    __host__ __device__ bool next(int i, Unit& u) const {
        const long L = (long)i * G + c; if (L >= nwg) return false;
        int wgid = (int)L; { const int q = nwg / NXCD, r = nwg % NXCD, xcd = wgid % NXCD, off = wgid / NXCD; wgid = (xcd < r ? xcd * (q + 1) : r * (q + 1) + (xcd - r) * q) + off; }
        const int nig = WGM * nN, gid = wgid / nig, fm = gid * WGM, gsz = (nM - fm) < WGM ? (nM - fm) : WGM;
        u.pm = fm + ((wgid % nig) % gsz); u.pn = (wgid % nig) / gsz; return true;
    }
    __device__ __forceinline__ void a_ready(const Unit&) const {}
    __device__ __forceinline__ void done(const Unit&) const {}
};


template <class Epi, class Sched, bool ALIGN_EPI = false, bool SP2 = false>
__device__ __forceinline__ void gemm_phase(PG8_LAS unsigned char* lds, const Gemm g, const Sched& S, const Epi& E) {
    const int tid = ::opaque_tid(), wid = __builtin_amdgcn_readfirstlane(tid >> 6), lane = tid & 63, wr = wid >> 2, wc = wid & 3, fr = lane & 15, fq = lane >> 4;
    const int K = g.K, nt = K / BK, LD = g.ld;
    unsigned voffA[2], voffB[2];
#pragma unroll
    for (int i = 0; i < 2; ++i) { int R, C; stage_rc(tid * 16 + i * 8192, R, C); const int Rb = Epi::PERM ? ((R & ~31) + perm32(R & 31)) : R;
        voffA[i] = (unsigned)(R * LD + C) * 2u; voffB[i] = (unsigned)(Rb * LD + C) * 2u; }
    const size_t kstep = (size_t)(BK * 2);
    const size_t hstep = (size_t)HALF * LD * 2;
    const size_t tstep = 2 * hstep;
    const unsigned ldsw = (unsigned)wid * 1024u;
    const int aoff = lds_byte(wr * 64 + fr, fq * 8), boff = lds_byte(wc * 32 + fr, fq * 8);
#define PG8_SA(b, h) (((b) * 2 + (h)) * HTB)
#define PG8_SB(b, h) ((4 + (b) * 2 + (h)) * HTB)
#define PG8_STAGE(bufoff, gbase, voff) do { _Pragma("unroll") for (int _i = 0; _i < 2; ++_i) \
        __builtin_amdgcn_global_load_lds((const unsigned*)((const char*)(gbase) + (voff)[_i]), (PG8_LAS unsigned*)(lds + (bufoff) + ldsw + _i * 8192), 16, 0, 0); } while (0)
#define PG8_LDA(dst, b, h) do { _Pragma("unroll") for (int m = 0; m < 4; ++m) _Pragma("unroll") for (int k = 0; k < 2; ++k) dst[m][k] = *(const PG8_LAS bf16x8*)(lds + PG8_SA(b, h) + aoff + m * 2048 + k * 1024); } while (0)
#define PG8_LDB(dst, b, h) do { _Pragma("unroll") for (int n = 0; n < 2; ++n) _Pragma("unroll") for (int k = 0; k < 2; ++k) dst[n][k] = *(const PG8_LAS bf16x8*)(lds + PG8_SB(b, h) + boff + n * 2048 + k * 1024); } while (0)
#define PG8_MMA(ai, bj, At, Bt) do { __builtin_amdgcn_s_setprio(1); _Pragma("unroll") for (int m = 0; m < 4; ++m) _Pragma("unroll") for (int n = 0; n < 2; ++n) _Pragma("unroll") for (int k = 0; k < 2; ++k) \
        acc[ai][bj][m][n] = __builtin_amdgcn_mfma_f32_16x16x32_bf16(Bt[n][k], At[m][k], acc[ai][bj][m][n], 0, 0, 0); __builtin_amdgcn_s_setprio(0); } while (0)
#define PG8_WAIT_V(n) asm volatile("s_waitcnt vmcnt(" #n ")" ::: "memory")
#define PG8_WAIT_L(n) asm volatile("s_waitcnt lgkmcnt(" #n ")" ::: "memory")
#define PG8_BAR __builtin_amdgcn_s_barrier()
#define PG8_SCHED __builtin_amdgcn_sched_barrier(0)
    Unit cur, nxt; int ui = 0;
    if (!S.next(0, cur)) return;
    f32x4 acc[2][2][4][2];
#pragma unroll
    for (int a = 0; a < 2; ++a)
#pragma unroll
        for (int b = 0; b < 2; ++b)
#pragma unroll
            for (int m = 0; m < 4; ++m)
#pragma unroll
                for (int n = 0; n < 2; ++n) acc[a][b][m][n] = (f32x4){0.f, 0.f, 0.f, 0.f};
    bf16x8 At[4][2], B0[2][2], B1[2][2];
    const char* cA = (const char*)g.A + (size_t)cur.pm * tstep; const char* cB = (const char*)g.Bt + (size_t)cur.pn * tstep;
    S.a_ready(cur);
    if constexpr (SP2) {
        PG8_STAGE(PG8_SB(0, 0), cB, voffB); PG8_STAGE(PG8_SB(0, 1), cB + hstep, voffB); PG8_STAGE(PG8_SA(0, 0), cA, voffA); PG8_STAGE(PG8_SA(0, 1), cA + hstep, voffA);
        if (wr == 1) PG8_BAR;
        PG8_WAIT_V(2); PG8_BAR;
        PG8_STAGE(PG8_SB(1, 0), cB + kstep, voffB); PG8_STAGE(PG8_SA(1, 0), cA + kstep, voffA); PG8_STAGE(PG8_SB(1, 1), cB + hstep + kstep, voffB);
        PG8_WAIT_V(6); PG8_BAR;
    } else {
        PG8_STAGE(PG8_SB(0, 0), cB, voffB); PG8_STAGE(PG8_SA(0, 0), cA, voffA); PG8_STAGE(PG8_SB(0, 1), cB + hstep, voffB); PG8_STAGE(PG8_SA(0, 1), cA + hstep, voffA);
        if (wr == 1) PG8_BAR;
        PG8_WAIT_V(4); PG8_BAR;
        PG8_STAGE(PG8_SB(1, 0), cB + kstep, voffB); PG8_STAGE(PG8_SA(1, 0), cA + kstep, voffA); PG8_STAGE(PG8_SB(1, 1), cB + hstep + kstep, voffB);
        PG8_WAIT_V(6); PG8_BAR;
    }
    for (;;) {
        const bool has_next = S.next(ui + 1, nxt);
        const char* nA = has_next ? (const char*)g.A + (size_t)nxt.pm * tstep : cA; const char* nB = has_next ? (const char*)g.Bt + (size_t)nxt.pn * tstep : cB;
        for (int t = 0; t < nt; t += 2) {
            const bool last = (t == nt - 2);
            const char* a1 = cA + (size_t)(t + 1) * kstep;
            const char* a2 = last ? nA : cA + (size_t)(t + 2) * kstep; const char* b2 = last ? nB : cB + (size_t)(t + 2) * kstep;
            const char* a3 = a2 + kstep; const char* b3 = b2 + kstep;
            if (last && has_next) S.a_ready(nxt);
            if constexpr (SP2) {
            PG8_LDB(B0, 0, 0); PG8_LDB(B1, 0, 1); PG8_SCHED; PG8_LDA(At, 0, 0); PG8_STAGE(PG8_SA(1, 1), a1 + hstep, voffA);
            PG8_WAIT_V(8); PG8_WAIT_L(0); PG8_BAR; PG8_MMA(0, 0, At, B0); PG8_MMA(0, 1, At, B1); PG8_BAR; PG8_SCHED;
            PG8_LDA(At, 0, 1); PG8_STAGE(PG8_SB(0, 0), b2, voffB); PG8_STAGE(PG8_SB(0, 1), b2 + hstep, voffB); PG8_STAGE(PG8_SA(0, 0), a2, voffA);
            PG8_WAIT_V(8); PG8_WAIT_L(0); PG8_BAR; PG8_MMA(1, 0, At, B0); PG8_MMA(1, 1, At, B1); PG8_BAR; PG8_SCHED;
            PG8_LDB(B0, 1, 0); PG8_LDB(B1, 1, 1); PG8_SCHED; PG8_LDA(At, 1, 0); PG8_STAGE(PG8_SA(0, 1), a2 + hstep, voffA);
            PG8_WAIT_V(8); PG8_WAIT_L(0); PG8_BAR; PG8_MMA(0, 0, At, B0); PG8_MMA(0, 1, At, B1); PG8_BAR; PG8_SCHED;
            PG8_LDA(At, 1, 1); PG8_STAGE(PG8_SB(1, 0), b3, voffB); PG8_STAGE(PG8_SB(1, 1), b3 + hstep, voffB); PG8_STAGE(PG8_SA(1, 0), a3, voffA);
            PG8_WAIT_V(8); PG8_WAIT_L(0); PG8_BAR; PG8_MMA(1, 0, At, B0); PG8_MMA(1, 1, At, B1); PG8_BAR; PG8_SCHED;
            } else {
            PG8_LDB(B0, 0, 0); PG8_SCHED; PG8_LDA(At, 0, 0); PG8_STAGE(PG8_SA(1, 1), a1 + hstep, voffA);
            PG8_WAIT_L(8); PG8_BAR; PG8_WAIT_L(0); PG8_MMA(0, 0, At, B0); PG8_BAR; PG8_SCHED;
            PG8_LDB(B1, 0, 1); PG8_STAGE(PG8_SB(0, 0), b2, voffB);
            PG8_BAR; PG8_WAIT_L(0); PG8_MMA(0, 1, At, B1); PG8_BAR;
            PG8_LDA(At, 0, 1); PG8_STAGE(PG8_SA(0, 0), a2, voffA);
            PG8_BAR; PG8_WAIT_L(0); PG8_MMA(1, 0, At, B0); PG8_BAR; PG8_SCHED;
            PG8_STAGE(PG8_SB(0, 1), b2 + hstep, voffB);
            PG8_WAIT_V(6); PG8_BAR; PG8_MMA(1, 1, At, B1); PG8_BAR;
            PG8_LDB(B0, 1, 0); PG8_SCHED; PG8_LDA(At, 1, 0); PG8_STAGE(PG8_SA(0, 1), a2 + hstep, voffA);
            PG8_WAIT_L(8); PG8_BAR; PG8_WAIT_L(0); PG8_MMA(0, 0, At, B0); PG8_BAR; PG8_SCHED;
            PG8_LDB(B1, 1, 1); PG8_STAGE(PG8_SB(1, 0), b3, voffB);
            PG8_BAR; PG8_WAIT_L(0); PG8_MMA(0, 1, At, B1); PG8_BAR;
            PG8_LDA(At, 1, 1); PG8_STAGE(PG8_SA(1, 0), a3, voffA);
            PG8_BAR; PG8_WAIT_L(0); PG8_MMA(1, 0, At, B0); PG8_BAR; PG8_SCHED;
            PG8_STAGE(PG8_SB(1, 1), b3 + hstep, voffB);
            PG8_WAIT_V(6); PG8_BAR; PG8_MMA(1, 1, At, B1); PG8_BAR;
            }
        }
        if constexpr (ALIGN_EPI) { if (wr == 0) PG8_BAR; }
        if constexpr (!Epi::AFTER_DRAIN) { E(acc, cur, wr, wc, fr, fq); S.done(cur); }
        if (!has_next) break;
#pragma unroll
        for (int a = 0; a < 2; ++a)
#pragma unroll
            for (int b = 0; b < 2; ++b)
#pragma unroll
                for (int m = 0; m < 4; ++m)
#pragma unroll
                    for (int n = 0; n < 2; ++n) acc[a][b][m][n] = (f32x4){0.f, 0.f, 0.f, 0.f};
        cur = nxt; cA = nA; cB = nB; ++ui;
        if constexpr (ALIGN_EPI) { if (wr == 1) PG8_BAR; }
    }
    PG8_WAIT_V(0);
    if constexpr (!ALIGN_EPI) { if (wr == 0) PG8_BAR; }
    PG8_BAR;
    if constexpr (Epi::AFTER_DRAIN) { E.fused(acc, cur, wr, wc, fr, fq, lds, wid, lane); S.done(cur); }
#undef PG8_SA
#undef PG8_SB
#undef PG8_STAGE
#undef PG8_LDA
#undef PG8_LDB
#undef PG8_MMA
#undef PG8_WAIT_V
#undef PG8_WAIT_L
#undef PG8_BAR
#undef PG8_SCHED
}
}
namespace attn {
using bf16 = __hip_bfloat16;
constexpr int   D = 128, NW = 8, QBLK = 32, KVBLK = 64;
constexpr float SCALE = 0.088388347648318440f;
constexpr float THR = 8.f;
constexpr int SDEPTH = 2;
constexpr int LDQ = 1024, LDK = 128, LDO = 1024;
constexpr size_t SHM_V = KVBLK * D * 2, SHM_K = KVBLK * D * 2, SHM_ATTN = 2 * SHM_V + 2 * SHM_K + NW * 64 * 4;
__device__ __forceinline__ unsigned f2bf_rne(float f) { unsigned u = __builtin_bit_cast(unsigned, f); return (u + 0x7fffu + ((u >> 16) & 1u)) >> 16; }
using bf16x8 = __attribute__((ext_vector_type(8))) short;
using s16x4  = __attribute__((ext_vector_type(4))) short;
using f32x16 = __attribute__((ext_vector_type(16))) float;
using f32x8  = __attribute__((ext_vector_type(8))) float;
using u32x4  = __attribute__((ext_vector_type(4))) unsigned;
#define KSWZ(row, colB) ((row) * 256 + ((colB) ^ (((row) & 7) << 4)))
#define SBAR() __builtin_amdgcn_sched_barrier(0)
__device__ __forceinline__ int crow(int r, int hi) { return (r & 3) + 8 * (r >> 2) + 4 * hi; }
__device__ __forceinline__ unsigned cvtpk(float lo, float hi) {
  unsigned r; asm volatile("v_cvt_pk_bf16_f32 %0, %1, %2" : "=v"(r) : "v"(lo), "v"(hi)); return r;
}
template <typename TIn> struct Stage;
template <> struct Stage<bf16>  { using T = bf16x8;
  __device__ static __forceinline__ T ld8(const bf16* p) { return *reinterpret_cast<const bf16x8*>(p); }
  __device__ static __forceinline__ bf16x8 tobf(T x) { return x; } };
template <> struct Stage<float> { using T = f32x8;
  __device__ static __forceinline__ T ld8(const float* p) { return *reinterpret_cast<const f32x8*>(p); }
  __device__ static __forceinline__ bf16x8 tobf(T x) {
    u32x4 w = {cvtpk(x[0], x[1]), cvtpk(x[2], x[3]), cvtpk(x[4], x[5]), cvtpk(x[6], x[7])}; return *reinterpret_cast<bf16x8*>(&w); } };

__device__ __forceinline__ void partialSM(f32x16& p0, f32x16& p1, float& m_reg, float& mn, float& alpha) {
  constexpr float C = SCALE * 1.4426950408889634f;
  float pmax = p0[0]; for (int r = 1; r < 16; ++r) pmax = fmaxf(pmax, p0[r]); for (int r = 0; r < 16; ++r) pmax = fmaxf(pmax, p1[r]);
  { auto rr = __builtin_amdgcn_permlane32_swap(__float_as_uint(pmax), __float_as_uint(pmax), false, false);
    pmax = fmaxf(__uint_as_float(rr[0]), __uint_as_float(rr[1])); }
  if (__builtin_expect(__all(pmax - m_reg <= THR / SCALE), 1)) { mn = m_reg; alpha = 1.f; }
  else { mn = fmaxf(m_reg, pmax); alpha = __builtin_amdgcn_exp2f((m_reg - mn) * C); m_reg = mn; }
  float mnC = -mn * C;
  for (int r = 0; r < 16; ++r) p0[r] = fmaf(p0[r], C, mnC); for (int r = 0; r < 16; ++r) p1[r] = fmaf(p1[r], C, mnC);
  for (int r = 0; r < 16; ++r) p0[r] = __builtin_amdgcn_exp2f(p0[r]);
}
__device__ __forceinline__ void finishSM(f32x16& p0, f32x16& p1, float alpha, float& l_reg, bf16x8& pa0, bf16x8& pa1, bf16x8& pa2, bf16x8& pa3) {
  for (int r = 0; r < 16; ++r) p1[r] = __builtin_amdgcn_exp2f(p1[r]);
  float ps = 0; for (int r = 0; r < 16; ++r) ps += p0[r]; for (int r = 0; r < 16; ++r) ps += p1[r];
  { auto rr = __builtin_amdgcn_permlane32_swap(__float_as_uint(ps), __float_as_uint(ps), false, false);
    ps = __uint_as_float(rr[0]) + __uint_as_float(rr[1]); }
  l_reg = l_reg * alpha + ps;
#define PK4(P, BASE, OUT) do { unsigned a0 = cvtpk(P[BASE + 0], P[BASE + 1]), a1 = cvtpk(P[BASE + 2], P[BASE + 3]);   \
    unsigned b0 = cvtpk(P[BASE + 4], P[BASE + 5]), b1 = cvtpk(P[BASE + 6], P[BASE + 7]);                              \
    auto r0 = __builtin_amdgcn_permlane32_swap(a0, b0, false, false); auto r1 = __builtin_amdgcn_permlane32_swap(a1, b1, false, false); \
    u32x4 w = {r0[0], r1[0], r0[1], r1[1]}; OUT = *reinterpret_cast<bf16x8*>(&w); } while (0)
  PK4(p0, 0, pa0); PK4(p0, 8, pa1); PK4(p1, 0, pa2); PK4(p1, 8, pa3);
#undef PK4
}
__device__ __forceinline__ void qkt(f32x16& p0, f32x16& p1, const bf16* Ks, const bf16x8* qr, int r32, int hi) {
  p0 = f32x16{}; p1 = f32x16{};
  for (int d0 = 0; d0 < 8; ++d0) { int cb = (d0 * 16 + hi * 8) * 2;
    bf16x8 b0 = *reinterpret_cast<const bf16x8*>((const char*)Ks + KSWZ(r32, cb));
    bf16x8 b1 = *reinterpret_cast<const bf16x8*>((const char*)Ks + KSWZ(32 + r32, cb));
    p0 = __builtin_amdgcn_mfma_f32_32x32x16_bf16(b0, qr[d0], p0, 0, 0, 0);
    p1 = __builtin_amdgcn_mfma_f32_32x32x16_bf16(b1, qr[d0], p1, 0, 0, 0); }
}
__device__ __forceinline__ int v_st(int k, int c) { const int kk = (k & ~0xC) | ((k & 4) << 1) | ((k & 8) >> 1); return ((kk >> 3) * 4 + (c >> 5)) * 512 + ((kk & 7) * 32 + (c & 31)) * 2; }
__device__ __forceinline__ int v_rd_base(int lane) { return ((lane & 3) << 3) | (((lane >> 2) & 3) << 6) | (((lane >> 4) & 1) << 5) | (((lane >> 5) & 1) << 8); }
constexpr int v_rd_off(int d0, int ks, int half) { return d0 * 512 + ks * 4096 + half * 2048; }
template <int OFF> __device__ __forceinline__ s16x4 tr_read(int vb) {
  s16x4 r; asm volatile("ds_read_b64_tr_b16 %0, %1 offset:%2" : "=&v"(r) : "v"(vb), "i"(OFF) : "memory"); return r;
}
template <int D0> __device__ __forceinline__ void pv_one(f32x16& od, int vb, bf16x8 pa0, bf16x8 pa1, bf16x8 pa2, bf16x8 pa3) {
  const s16x4 l0 = tr_read<v_rd_off(D0, 0, 0)>(vb), h0 = tr_read<v_rd_off(D0, 0, 1)>(vb), l1 = tr_read<v_rd_off(D0, 1, 0)>(vb), h1 = tr_read<v_rd_off(D0, 1, 1)>(vb);
  const s16x4 l2 = tr_read<v_rd_off(D0, 2, 0)>(vb), h2 = tr_read<v_rd_off(D0, 2, 1)>(vb), l3 = tr_read<v_rd_off(D0, 3, 0)>(vb), h3 = tr_read<v_rd_off(D0, 3, 1)>(vb);
  asm volatile("s_waitcnt lgkmcnt(0)" ::: "memory"); SBAR();
#define PK(L, H) (bf16x8){L[0], L[1], L[2], L[3], H[0], H[1], H[2], H[3]}
  od = __builtin_amdgcn_mfma_f32_32x32x16_bf16(pa0, PK(l0, h0), od, 0, 0, 0);
  od = __builtin_amdgcn_mfma_f32_32x32x16_bf16(pa1, PK(l1, h1), od, 0, 0, 0);
  od = __builtin_amdgcn_mfma_f32_32x32x16_bf16(pa2, PK(l2, h2), od, 0, 0, 0);
  od = __builtin_amdgcn_mfma_f32_32x32x16_bf16(pa3, PK(l3, h3), od, 0, 0, 0);
#undef PK
}
__device__ __forceinline__ void pv_d0(f32x16* o, int vb, bf16x8 pa0, bf16x8 pa1, bf16x8 pa2, bf16x8 pa3) {
  pv_one<0>(o[0], vb, pa0, pa1, pa2, pa3); pv_one<1>(o[1], vb, pa0, pa1, pa2, pa3); pv_one<2>(o[2], vb, pa0, pa1, pa2, pa3); pv_one<3>(o[3], vb, pa0, pa1, pa2, pa3);
}

template <typename TQ>
__device__ __forceinline__ void attn_dense_body(const TQ* __restrict__ Qb, const bf16* __restrict__ Kh, const bf16* __restrict__ Vh,
                                                unsigned short* __restrict__ Ob, int seq, char* lds) {
  using St = Stage<bf16>; using SQ = Stage<TQ>;
  const int tid = ::opaque_tid(), wid = tid >> 6, lane = tid & 63, r32 = lane & 31, hi = lane >> 5;
  bf16* V_lds = (bf16*)lds; bf16* K_lds = (bf16*)(lds + 2 * SHM_V);
  float* ws = (float*)(lds + 2 * SHM_V + 2 * SHM_K) + wid * 64; float* li_l = ws; float* al_l = ws + 32;
  float m_reg = -1e30f, l_reg = 0; f32x16 o[4] = {}; bf16x8 qr[8];
  const TQ* Qw = Qb + (long)(wid * QBLK + r32) * LDQ + hi * 8;
#pragma unroll
  for (int d0 = 0; d0 < 8; ++d0) qr[d0] = SQ::tobf(SQ::ld8(Qw + d0 * 16));
  const int sr = tid >> 4, sc = (tid & 15) * 8, vst0 = v_st(sr, sc), vst1 = v_st(32 + sr, sc);
  const int vb0 = (int)(uintptr_t)V_lds + v_rd_base(lane);
  struct { typename St::T vs0, vs1, ks0, ks1; } sr_[SDEPTH];
#define SLOAD(i, k0) do { sr_[i].vs0 = St::ld8(&Vh[(long)((k0) + sr) * LDK + sc]); sr_[i].vs1 = St::ld8(&Vh[(long)((k0) + 32 + sr) * LDK + sc]); \
    sr_[i].ks0 = St::ld8(&Kh[(long)((k0) + sr) * LDK + sc]); sr_[i].ks1 = St::ld8(&Kh[(long)((k0) + 32 + sr) * LDK + sc]); } while (0)
#define SWRITE(b, i) do { *(bf16x8*)((char*)V_lds + (b) * SHM_V + vst0) = St::tobf(sr_[i].vs0);          \
    *(bf16x8*)((char*)V_lds + (b) * SHM_V + vst1) = St::tobf(sr_[i].vs1); int kc = sc * 2;               \
    *(bf16x8*)((char*)K_lds + (b) * SHM_K + KSWZ(sr, kc)) = St::tobf(sr_[i].ks0);                       \
    *(bf16x8*)((char*)K_lds + (b) * SHM_K + KSWZ(32 + sr, kc)) = St::tobf(sr_[i].ks1); } while (0)
#define SWAIT() do { if constexpr (SDEPTH == 2) asm volatile("s_waitcnt vmcnt(4)" ::: "memory"); else asm volatile("s_waitcnt vmcnt(0)" ::: "memory"); } while (0)
#define RESC(a) do { if (__any((a) < 1.f)) { if (hi == 0) al_l[r32] = (a); asm volatile("s_waitcnt lgkmcnt(0)" ::: "memory"); \
    for (int d = 0; d < 4; ++d) for (int r = 0; r < 16; ++r) o[d][r] *= al_l[crow(r, hi)]; } } while (0)
  f32x16 pA0, pA1, pB0, pB1; float mnA, mnB, alA, alB; bf16x8 pa0, pa1, pa2, pa3; const int NT = seq / KVBLK;
  constexpr int SE = 0, SO = SDEPTH - 1;
  SLOAD(SE, 0); asm volatile("s_waitcnt vmcnt(0)" ::: "memory"); SWRITE(0, SE); __syncthreads();
  qkt(pA0, pA1, K_lds, qr, r32, hi); partialSM(pA0, pA1, m_reg, mnA, alA);
  SLOAD(SO, KVBLK); if constexpr (SDEPTH == 2) { if (2 < NT) SLOAD(SE, 2 * KVBLK); }
  SWAIT(); SWRITE(1, SO); __syncthreads();
  for (int j = 1; j + 1 < NT; j += 2) {
    SBAR(); qkt(pB0, pB1, (bf16*)((char*)K_lds + SHM_K), qr, r32, hi);
    finishSM(pA0, pA1, alA, l_reg, pa0, pa1, pa2, pa3); SBAR();
    SLOAD(SO, (j + SDEPTH) * KVBLK); SBAR();
    pv_d0(o, vb0, pa0, pa1, pa2, pa3); partialSM(pB0, pB1, m_reg, mnB, alB);
    __syncthreads(); SWAIT(); SWRITE(0, SE);
    RESC(alB); __syncthreads();
    SBAR(); qkt(pA0, pA1, K_lds, qr, r32, hi);
    finishSM(pB0, pB1, alB, l_reg, pa0, pa1, pa2, pa3); SBAR();
    if (SDEPTH == 1 || j + 3 < NT) SLOAD(SE, (j + 1 + SDEPTH) * KVBLK); SBAR();
    pv_d0(o, vb0 + (int)SHM_V, pa0, pa1, pa2, pa3); partialSM(pA0, pA1, m_reg, mnA, alA);
    __syncthreads(); SWAIT(); SWRITE(1, SO);
    RESC(alA); __syncthreads();
  }
  SBAR(); qkt(pB0, pB1, (bf16*)((char*)K_lds + SHM_K), qr, r32, hi);
  finishSM(pA0, pA1, alA, l_reg, pa0, pa1, pa2, pa3); SBAR();
  pv_d0(o, vb0, pa0, pa1, pa2, pa3); partialSM(pB0, pB1, m_reg, mnB, alB);
  __syncthreads(); RESC(alB);
  finishSM(pB0, pB1, alB, l_reg, pa0, pa1, pa2, pa3); SBAR();
  pv_d0(o, vb0 + (int)SHM_V, pa0, pa1, pa2, pa3);
  if (hi == 0) li_l[r32] = l_reg; asm volatile("s_waitcnt lgkmcnt(0)" ::: "memory");
  float rli[16];
#pragma unroll
  for (int r = 0; r < 16; ++r) rli[r] = __builtin_amdgcn_rcpf(li_l[crow(r, hi)]);
  __syncthreads();
  unsigned short* Os = (unsigned short*)lds + wid * (32 * 136);
#pragma unroll
  for (int r = 0; r < 16; ++r) { const int orow = crow(r, hi);
#pragma unroll
    for (int d0 = 0; d0 < 4; ++d0) Os[orow * 136 + d0 * 32 + r32] = (unsigned short)f2bf_rne(o[d0][r] * rli[r]); }
  asm volatile("s_waitcnt lgkmcnt(0)" ::: "memory");
  unsigned short* Ow = Ob + (long)(wid * QBLK) * LDO;
#pragma unroll
  for (int i = 0; i < 8; ++i) { const int cidx = lane + 64 * i, row = cidx >> 4, seg = cidx & 15;
    const u32x4 v = *reinterpret_cast<const u32x4*>(Os + row * 136 + seg * 8);
    *reinterpret_cast<u32x4*>(Ow + (long)row * LDO + seg * 8) = v; }
#undef SLOAD
#undef SWRITE
#undef SWAIT
#undef RESC
}

#undef KSWZ
#undef SBAR
}
#define XB_TMO      128
#define XB_XCNT(j)  (256  + 64 * (j))
#define XB_XSUB(j)  (1280 + 64 * (j))
#define XB_XGEN(j)  (2304 + 64 * (j))
#define XB_TOP      3328
#define XB_TOPGEN   3392
#define XCD_BAR_WORDS 3456
#define XB_SPIN_CAP (1u << 18)

__device__ __forceinline__ unsigned xb_ld(unsigned* p)              { return __hip_atomic_load(p, __ATOMIC_RELAXED, __HIP_MEMORY_SCOPE_AGENT); }
__device__ __forceinline__ unsigned xb_add(unsigned* p, unsigned v) { return __hip_atomic_fetch_add(p, v, __ATOMIC_RELAXED, __HIP_MEMORY_SCOPE_AGENT); }
__device__ __forceinline__ unsigned xb_xcc_id() { return (unsigned)__builtin_amdgcn_s_getreg((3 << 11) | 20) & 0xFu; }
#define XB_SPIN(cond, bar) do { unsigned _sp = 0; while (cond) { __builtin_amdgcn_s_sleep(1); \
    if ((++_sp & 255u) == 0u) { if (xb_ld(&(bar)[XB_TMO])) break; if (_sp > XB_SPIN_CAP) { atomicAdd(&(bar)[XB_TMO], 1u); break; } } } } while (0)

struct XcdBarrier {
    unsigned* bar; unsigned x;
    volatile LAS unsigned* st;
};

__device__ __forceinline__ XcdBarrier xcd_barrier_post(unsigned* bar, volatile LAS unsigned* st) {
    XcdBarrier b; b.bar = bar; b.x = xb_xcc_id(); b.st = st;
    if (threadIdx.x == 0) (void)xb_add(&bar[XB_XCNT(b.x)], 1u);
    return b;
}
__device__ __forceinline__ void xcd_barrier_complete(unsigned* bar, unsigned x, unsigned& nloc, unsigned& nx) {
    const unsigned G = gridDim.x * gridDim.y * gridDim.z;
    unsigned sum, cnt, mine, sp = 0u;
    for (;;) {
        sum = 0u; cnt = 0u; mine = 0u;
#pragma unroll
        for (unsigned j = 0; j < 16; ++j) { const unsigned c = xb_ld(&bar[XB_XCNT(j)]); sum += c; cnt += (c > 0u) ? 1u : 0u; mine = (j == x) ? c : mine; }
        if (sum == G) break;
        __builtin_amdgcn_s_sleep(1);
        if ((++sp & 255u) == 0u) { if (xb_ld(&bar[XB_TMO])) break; if (sp > XB_SPIN_CAP) { atomicAdd(&bar[XB_TMO], 1u); break; } }
    }
    nloc = mine > 0u ? mine : 1u; nx = cnt > 0u ? cnt : 1u;
}

__device__ __forceinline__ void xcd_barrier(const XcdBarrier& b) {
    asm volatile("s_waitcnt vmcnt(0)" ::: "memory");
    __syncthreads();
    if (threadIdx.x == 0) {
        unsigned* bar = b.bar;
        __builtin_amdgcn_s_waitcnt(0);
        unsigned nloc = b.st[0], nx = b.st[1];
        if (nloc == 0u) { xcd_barrier_complete(bar, b.x, nloc, nx); b.st[0] = nloc; b.st[1] = nx; }
        const unsigned old = xb_add(&bar[XB_XSUB(b.x)], 1u);
        const unsigned gen = old / nloc;
        if (old + 1u == (gen + 1u) * nloc) {
            __builtin_amdgcn_fence(__ATOMIC_RELEASE, "agent");
            asm volatile("s_waitcnt vmcnt(0)" ::: "memory");
            const unsigned og = xb_add(&bar[XB_TOP], 1u);
            const unsigned tg = og / nx;
            if (og + 1u == (tg + 1u) * nx) xb_add(&bar[XB_TOPGEN], 1u);
            else XB_SPIN(xb_ld(&bar[XB_TOPGEN]) == tg, bar);
            __builtin_amdgcn_fence(__ATOMIC_ACQUIRE, "agent");
            xb_add(&bar[XB_XGEN(b.x)], 1u);
            asm volatile("s_waitcnt vmcnt(0)" ::: "memory");
        } else {
            XB_SPIN(xb_ld(&bar[XB_XGEN(b.x)]) == gen, bar);
            __builtin_amdgcn_fence(__ATOMIC_ACQUIRE, "agent");
            asm volatile("s_waitcnt vmcnt(0)" ::: "memory");
        }
    }
    __syncthreads();
}

using pg8::bf16_t; using pg8::f32x4; using pg8::u32x4; using pg8::bf16x8; using pg8::Unit;
typedef unsigned u32x2 __attribute__((ext_vector_type(2)));
typedef float f32x16 __attribute__((ext_vector_type(16)));

constexpr int DM = 1024, NB = 8, SEQ = 4096, NCTX = 256, ML = NB * SEQ, MC = NB * NCTX, MT = ML + MC;
constexpr int DFF = 2752, HP = 2816, NGU = 2 * HP;
constexpr int KEYS = SEQ + NCTX;
constexpr float EPS = 1e-6f;
constexpr int NTHR = 512, NWAVE = 8;
constexpr int LDS_BYTES = 147456;

constexpr size_t AL(size_t x) { return (x + 255) & ~(size_t)255; }
constexpr size_t O_ROWSS = 0;
constexpr size_t O_BAR   = AL(O_ROWSS + (size_t)13 * MT * 4);
constexpr size_t O_MODS  = AL(O_BAR + (size_t)XCD_BAR_WORDS * 4);
constexpr size_t O_GS    = AL(O_MODS + (size_t)4 * 9 * 9216 * 4);
constexpr size_t O_GT    = AL(O_GS + (size_t)12 * 9 * 1024 * 4);
constexpr size_t O_SW    = AL(O_GT + (size_t)12 * 9 * 1024 * 4);
constexpr size_t O_SP    = AL(O_SW + (size_t)12 * 9 * NGU * 4);
constexpr size_t O_WSB   = AL(O_SP + (size_t)12 * 256 * 1024 * 2);
constexpr size_t O_XC    = AL(O_WSB + (size_t)2 * 4 * 128 * 128 * 2);
constexpr size_t O_XG    = AL(O_XC + (size_t)MC * 1024 * 4);
constexpr size_t O_MIXA  = AL(O_XG + (size_t)MT * 1024 * 2);
constexpr size_t O_H     = AL(O_MIXA + (size_t)MT * 1024 * 2);
constexpr size_t SZ_H    = (size_t)MT * HP * 2;
constexpr size_t O_UV    = O_H;
constexpr size_t O_FT    = AL(O_UV + (size_t)MT * 1024 * 2);
constexpr size_t O_FTC   = AL(O_FT + (size_t)4096 * 8192 * 2);
constexpr size_t O_QKRAW = O_H;
constexpr size_t O_WF    = O_H;
static_assert(O_FTC + (size_t)4096 * 512 * 2 <= O_H + SZ_H, "H overlay");
static_assert((size_t)MT * 1280 * 4 <= SZ_H, "H overlay qk");
constexpr size_t O_DFT   = AL(O_H + SZ_H);
constexpr size_t O_KB    = AL(O_DFT + (size_t)2048 * 8192 * 2);
constexpr size_t O_VB    = AL(O_KB + (size_t)NB * 2 * KEYS * 128 * 2);
constexpr size_t O_DFTC  = AL(O_VB + (size_t)NB * 2 * KEYS * 128 * 2);
constexpr size_t O_W     = AL(O_DFTC + (size_t)256 * 512 * 2);
constexpr size_t SZ_WGU = (size_t)NGU * 1024 * 2, SZ_WD = (size_t)1024 * HP * 2, SZ_WM = (size_t)1024 * 1024 * 2;
constexpr size_t W_GU1 = 0, W_D1 = SZ_WGU, W_GU2 = W_D1 + SZ_WD, W_D2 = W_GU2 + SZ_WGU, W_MIX = W_D2 + SZ_WD;
constexpr size_t SZ_WL = W_MIX + 3 * SZ_WM;
constexpr size_t WS_END = O_W + 4 * SZ_WL;

struct Params { const float* in[23]; float* out; unsigned char* ws; int st_lo, st_hi; };

enum { I_X = 0, I_C, I_CTX, I_CCTX, I_WMOD, I_BMOD, I_GFFN1, I_WGU1, I_WD1, I_GMIX, I_GFFN2, I_WGU2, I_WD2, I_GFINAL, I_WIN, I_GV, I_WS, I_BS, I_WOUT, I_WQKV, I_GQ, I_GK, I_WO };

__device__ __forceinline__ unsigned f2bf(float f) { unsigned u = __builtin_bit_cast(unsigned, f); return (u + 0x7fffu + ((u >> 16) & 1u)) >> 16; }
__device__ __forceinline__ unsigned pk2(float lo, float hi) { unsigned r; asm volatile("v_cvt_pk_bf16_f32 %0, %1, %2" : "=v"(r) : "v"(lo), "v"(hi)); return r; }
__device__ __forceinline__ float bf2f(unsigned short h) { return __builtin_bit_cast(float, (unsigned)h << 16); }
__device__ __forceinline__ float silu_f(float g) { return g * __builtin_amdgcn_rcpf(1.0f + __builtin_amdgcn_exp2f(-1.4426950408889634f * g)); }
__device__ __forceinline__ float gelu_tanh_f(float v) {
    const float z2 = v * (1.5957691216057308f + 0.07135481627159493f * v * v);
    return v * __builtin_amdgcn_rcpf(1.0f + __builtin_amdgcn_exp2f(-1.4426950408889634f * z2));
}
__device__ __forceinline__ int mb_of_panel(int pm) { return pm < 128 ? (pm >> 4) : 8; }
__device__ __forceinline__ float rstd_of(float ss) { return __builtin_amdgcn_rsqf(ss * (1.0f / 1024.0f) + EPS); }

typedef float f32x2v __attribute__((ext_vector_type(2)));
struct EpiGU {
    static constexpr bool PERM = true, AFTER_DRAIN = false;
    bf16_t* H; const float* rowss; const float* sw;
    __device__ __forceinline__ void operator()(const f32x4 (&acc)[2][2][4][2], const Unit& u, int wr, int wc, int fr_, int fq_) const {
        const int tl_ = opaque_tid(); const int fr = tl_ & 15, fq = (tl_ >> 4) & 3; (void)fr_; (void)fq_;
        const int mb = mb_of_panel(u.pm), row0 = u.pm * 256 + wr * 64 + fr, hc0 = u.pn * 128 + wc * 32 + 8 * fq;
        const float* swg = sw + (size_t)mb * NGU + u.pn * 256 + wc * 32 + 8 * fq;
        f32x4 bg[2], bu[2];
#pragma unroll
        for (int n = 0; n < 2; ++n) { bg[n] = *(const f32x4*)(swg + 4 * n); bu[n] = *(const f32x4*)(swg + 128 + 4 * n); }
        float rsv[2][4];
#pragma unroll
        for (int ai = 0; ai < 2; ++ai)
#pragma unroll
            for (int m = 0; m < 4; ++m) rsv[ai][m] = rstd_of(rowss[row0 + ai * 128 + m * 16]);
#pragma unroll
        for (int ai = 0; ai < 2; ++ai)
#pragma unroll
            for (int m = 0; m < 4; ++m) {
                const int r = row0 + ai * 128 + m * 16; const float rs = rsv[ai][m];
                f32x2v g[4], up[4], e[4];
#pragma unroll
                for (int n = 0; n < 2; ++n) { const f32x4 gv = acc[ai][0][m][n] * rs + bg[n], uv = acc[ai][1][m][n] * rs + bu[n];
                    g[2 * n] = (f32x2v){gv[0], gv[1]}; g[2 * n + 1] = (f32x2v){gv[2], gv[3]}; up[2 * n] = (f32x2v){uv[0], uv[1]}; up[2 * n + 1] = (f32x2v){uv[2], uv[3]}; }
#pragma unroll
                for (int q = 0; q < 4; ++q) { const f32x2v t = g[q] * -1.4426950408889634f; e[q].x = __builtin_amdgcn_exp2f(t.x); e[q].y = __builtin_amdgcn_exp2f(t.y); }
#pragma unroll
                for (int q = 0; q < 4; ++q) { const f32x2v d = e[q] + 1.0f; e[q].x = __builtin_amdgcn_rcpf(d.x); e[q].y = __builtin_amdgcn_rcpf(d.y); }
#pragma unroll
                for (int q = 0; q < 4; ++q) g[q] = (g[q] * e[q]) * up[q];
                u32x4 w; w.x = pk2(g[0].x, g[0].y); w.y = pk2(g[1].x, g[1].y); w.z = pk2(g[2].x, g[2].y); w.w = pk2(g[3].x, g[3].y);
                *(u32x4*)(H + (size_t)r * HP + hc0) = w;
            }
    }
};

struct EpiRes {
    static constexpr bool PERM = true, AFTER_DRAIN = false;
    float* xl; float* xc; const float* gate; const float* gsn; bf16_t* xg; float* rowss_next; const float* xil; const float* xic;
    __device__ __forceinline__ void operator()(const f32x4 (&acc)[2][2][4][2], const Unit& u, int wr, int wc, int fr_, int fq_) const {
        const int tl_ = opaque_tid(); const int fr = tl_ & 15, fq = (tl_ >> 4) & 3; (void)fr_; (void)fq_;
        const int mb = mb_of_panel(u.pm);
        float* xb = u.pm < 128 ? xl + (size_t)u.pm * 256 * 1024 : xc + (size_t)(u.pm - 128) * 256 * 1024;
        const float* xib = u.pm < 128 ? xil + (size_t)u.pm * 256 * 1024 : xic + (size_t)(u.pm - 128) * 256 * 1024;
        const int lr0 = wr * 64 + fr, col0 = u.pn * 256 + wc * 32 + 8 * fq;
        float* xbase = xb + (size_t)lr0 * 1024 + col0; const float* xibase = xib + (size_t)lr0 * 1024 + col0;
        bf16_t* gbase = xg + ((size_t)u.pm * 256 + lr0) * 1024 + col0;
        float ss[4];
        f32x4 xa[4][2], xbf[4][2];
#define RES_LOAD(buf, bj, ai) do { _Pragma("unroll") for (int m = 0; m < 4; ++m) { const float* px = xibase + (size_t)((ai) * 128 + m * 16) * 1024 + (bj) * 128; buf[m][0] = *(const f32x4*)px; buf[m][1] = *(const f32x4*)(px + 4); } asm volatile("" ::: "memory"); } while (0)
#define RES_PROC(buf, bj, ai) do { const f32x4 gv0 = *(const f32x4*)(gate + mb * 1024 + col0 + (bj) * 128), gv1 = *(const f32x4*)(gate + mb * 1024 + col0 + (bj) * 128 + 4); \
        f32x4 gs0 = (f32x4){0.f, 0.f, 0.f, 0.f}, gs1 = gs0; if (gsn) { gs0 = *(const f32x4*)(gsn + mb * 1024 + col0 + (bj) * 128); gs1 = *(const f32x4*)(gsn + mb * 1024 + col0 + (bj) * 128 + 4); } \
        _Pragma("unroll") for (int m = 0; m < 4; ++m) { float* px = xbase + (size_t)((ai) * 128 + m * 16) * 1024 + (bj) * 128; \
            const f32x4 xn0 = buf[m][0] + gv0 * acc[ai][bj][m][0], xn1 = buf[m][1] + gv1 * acc[ai][bj][m][1]; \
            *(f32x4*)px = xn0; *(f32x4*)(px + 4) = xn1; \
            const float sq = ((xn0[0] * xn0[0] + xn0[1] * xn0[1]) + (xn0[2] * xn0[2] + xn0[3] * xn0[3])) + ((xn1[0] * xn1[0] + xn1[1] * xn1[1]) + (xn1[2] * xn1[2] + xn1[3] * xn1[3])); \
            ss[m] = (bj) ? ss[m] + sq : sq; \
            if (gsn) { const f32x4 xs0 = xn0 * gs0, xs1 = xn1 * gs1; u32x4 w; w.x = pk2(xs0[0], xs0[1]); w.y = pk2(xs0[2], xs0[3]); w.z = pk2(xs1[0], xs1[1]); w.w = pk2(xs1[2], xs1[3]); \
                *(u32x4*)(gbase + (size_t)((ai) * 128 + m * 16) * 1024 + (bj) * 128) = w; } } asm volatile("" ::: "memory"); } while (0)
#define RES_ATOM(ai) do { _Pragma("unroll") for (int m = 0; m < 4; ++m) { float sv = ss[m]; sv += __shfl_xor(sv, 16); sv += __shfl_xor(sv, 32); \
            if (fq == 0) unsafeAtomicAdd(rowss_next + (size_t)u.pm * 256 + lr0 + (ai) * 128 + m * 16, sv); } } while (0)
        RES_LOAD(xa, 0, 0);
        RES_LOAD(xbf, 1, 0); RES_PROC(xa, 0, 0);
        RES_LOAD(xa, 0, 1); RES_PROC(xbf, 1, 0); RES_ATOM(0);
        RES_LOAD(xbf, 1, 1); RES_PROC(xa, 0, 1);
        RES_PROC(xbf, 1, 1); RES_ATOM(1);
#undef RES_LOAD
#undef RES_PROC
#undef RES_ATOM
    }
};

struct EpiUV {
    static constexpr bool PERM = true, AFTER_DRAIN = false;
    bf16_t* O; const float* rowss; const float* sw;
    __device__ __forceinline__ void operator()(const f32x4 (&acc)[2][2][4][2], const Unit& u, int wr, int wc, int fr_, int fq_) const {
        const int tl_ = opaque_tid(); const int fr = tl_ & 15, fq = (tl_ >> 4) & 3; (void)fr_; (void)fq_;
        const int mb = mb_of_panel(u.pm), row0 = u.pm * 256 + wr * 64 + fr, col0 = u.pn * 256 + wc * 32 + 8 * fq;
        f32x4 bv[2][2];
#pragma unroll
        for (int bj = 0; bj < 2; ++bj)
#pragma unroll
            for (int n = 0; n < 2; ++n) bv[bj][n] = *(const f32x4*)(sw + (size_t)mb * NGU + col0 + bj * 128 + 4 * n);
#pragma unroll
        for (int ai = 0; ai < 2; ++ai)
#pragma unroll
            for (int m = 0; m < 4; ++m) {
                const int r = row0 + ai * 128 + m * 16; const float rs = rstd_of(rowss[r]);
#pragma unroll
                for (int bj = 0; bj < 2; ++bj) {
                    const f32x4 v0 = acc[ai][bj][m][0] * rs + bv[bj][0], v1 = acc[ai][bj][m][1] * rs + bv[bj][1];
                    u32x4 w; w.x = pk2(gelu_tanh_f(v0[0]), gelu_tanh_f(v0[1])); w.y = pk2(gelu_tanh_f(v0[2]), gelu_tanh_f(v0[3]));
                    w.z = pk2(gelu_tanh_f(v1[0]), gelu_tanh_f(v1[1])); w.w = pk2(gelu_tanh_f(v1[2]), gelu_tanh_f(v1[3]));
                    *(u32x4*)(O + (size_t)r * 1024 + col0 + bj * 128) = w;
                }
            }
    }
};

struct EpiFT {
    static constexpr bool PERM = true, AFTER_DRAIN = false;
    bf16_t* FT; bf16_t* FTC; const float* rowss; const float* sw;
    __device__ __forceinline__ void operator()(const f32x4 (&acc)[2][2][4][2], const Unit& u, int wr, int wc, int fr_, int fq_) const {
        const int tl_ = opaque_tid(); const int fr = tl_ & 15, fq = (tl_ >> 4) & 3; (void)fr_; (void)fq_;
        const int mb = mb_of_panel(u.pn), tok0 = u.pn * 256 + wc * 32 + 8 * fq;
        f32x4 rs[2][2];
#pragma unroll
        for (int bj = 0; bj < 2; ++bj)
#pragma unroll
            for (int n = 0; n < 2; ++n) { const f32x4 s = *(const f32x4*)(rowss + tok0 + bj * 128 + 4 * n);
                rs[bj][n] = (f32x4){rstd_of(s[0]), rstd_of(s[1]), rstd_of(s[2]), rstd_of(s[3])}; }
#pragma unroll
        for (int ai = 0; ai < 2; ++ai)
#pragma unroll
            for (int m = 0; m < 4; ++m) {
                const int ch = u.pm * 256 + ai * 128 + wr * 64 + m * 16 + fr, part = ch >> 9, c = ch & 511;
                const float swv = sw[(size_t)mb * NGU + ch];
#pragma unroll
                for (int bj = 0; bj < 2; ++bj) {
                    const f32x4 v0 = acc[ai][bj][m][0] * rs[bj][0] + swv, v1 = acc[ai][bj][m][1] * rs[bj][1] + swv;
                    u32x4 w; w.x = pk2(v0[0], v0[1]); w.y = pk2(v0[2], v0[3]); w.z = pk2(v1[0], v1[1]); w.w = pk2(v1[2], v1[3]);
                    bf16_t* dst;
                    if (u.pn < 128) { const int b = u.pn >> 4, npos = (u.pn & 15) * 256 + bj * 128 + wc * 32 + 8 * fq; dst = FT + ((size_t)(b * 512 + c) * 8192 + part * 4096 + npos); }
                    else { const int b = u.pn - 128, npos = bj * 128 + wc * 32 + 8 * fq; dst = FTC + ((size_t)(b * 512 + c) * 512 + part * 256 + npos); }
                    *(u32x4*)dst = w;
                }
            }
    }
};

struct EpiDFT {
    static constexpr bool PERM = true, AFTER_DRAIN = false;
    bf16_t* O; int rows_per_b, row_base;
    __device__ __forceinline__ void operator()(const f32x4 (&acc)[2][2][4][2], const Unit& u, int wr, int wc, int fr_, int fq_) const {
        const int tl_ = opaque_tid(); const int fr = tl_ & 15, fq = (tl_ >> 4) & 3; (void)fr_; (void)fq_;
        const int b = u.pn >> 1;
        bf16_t* base = O + (size_t)(row_base + b * rows_per_b + u.pm * 256 + wr * 64 + fr) * 1024 + (u.pn & 1) * 256 + wc * 32 + 8 * fq;
#pragma unroll
        for (int ai = 0; ai < 2; ++ai)
#pragma unroll
            for (int m = 0; m < 4; ++m) {
                bf16_t* rowp = base + (size_t)(ai * 128 + m * 16) * 1024;
#pragma unroll
                for (int bj = 0; bj < 2; ++bj) {
                    const f32x4 v0 = acc[ai][bj][m][0], v1 = acc[ai][bj][m][1];
                    u32x4 w; w.x = pk2(v0[0], v0[1]); w.y = pk2(v0[2], v0[3]); w.z = pk2(v1[0], v1[1]); w.w = pk2(v1[2], v1[3]);
                    *(u32x4*)(rowp + bj * 128) = w;
                }
                if (m & 1) asm volatile("" ::: "memory");
            }
    }
};

struct EpiQKV {
    static constexpr bool PERM = false, AFTER_DRAIN = false;
    bf16_t* qk; bf16_t* vb; const float* rowss; const float* sw;
    __device__ __forceinline__ void operator()(const f32x4 (&acc)[2][2][4][2], const Unit& u, int wr, int wc, int fr_, int fq_) const {
        const int tl_ = opaque_tid(); const int fr = tl_ & 15, fq = (tl_ >> 4) & 3; (void)fr_; (void)fq_;
        const int mb = mb_of_panel(u.pm), lr0 = wr * 64 + fr, col0 = u.pn * 256 + wc * 32 + 4 * fq;
        f32x4 bv[2][2];
#pragma unroll
        for (int bj = 0; bj < 2; ++bj)
#pragma unroll
            for (int n = 0; n < 2; ++n) bv[bj][n] = *(const f32x4*)(sw + (size_t)mb * NGU + col0 + bj * 128 + n * 16);
#pragma unroll
        for (int ai = 0; ai < 2; ++ai)
#pragma unroll
            for (int m = 0; m < 4; ++m) {
                const int lr = lr0 + ai * 128 + m * 16, r = u.pm * 256 + lr; const float rs = rstd_of(rowss[r]);
#pragma unroll
                for (int bj = 0; bj < 2; ++bj)
#pragma unroll
                    for (int n = 0; n < 2; ++n) {
                        const f32x4 v = acc[ai][bj][m][n] * rs + bv[bj][n];
                        if (u.pn < 5) { u32x2 w; w.x = pk2(v[0], v[1]); w.y = pk2(v[2], v[3]); *(u32x2*)(qk + (size_t)r * 1280 + col0 + bj * 128 + n * 16) = w; }
                        else { const int d = wc * 32 + 16 * n + 4 * fq; int b, key;
                            if (u.pm < 128) { b = u.pm >> 4; key = (u.pm & 15) * 256 + lr; } else { b = u.pm - 128; key = SEQ + lr; }
                            u32x2 w; w.x = pk2(v[0], v[1]); w.y = pk2(v[2], v[3]);
                            *(u32x2*)(vb + ((size_t)(b * 2 + bj) * KEYS + key) * 128 + d) = w; }
                    }
            }
    }
};

struct EpiPart {
    static constexpr bool PERM = true, AFTER_DRAIN = false;
    float* slab; int ld;
    __device__ __forceinline__ void operator()(const f32x4 (&acc)[2][2][4][2], const Unit& u, int wr, int wc, int fr_, int fq_) const {
        const int tl_ = opaque_tid(); const int fr = tl_ & 15, fq = (tl_ >> 4) & 3; (void)fr_; (void)fq_;
        float* base = slab + (size_t)(u.pm * 256 + wr * 64 + fr) * ld + u.pn * 256 + wc * 32 + 8 * fq;
#pragma unroll
        for (int ai = 0; ai < 2; ++ai)
#pragma unroll
            for (int m = 0; m < 4; ++m) { float* rowp = base + (size_t)(ai * 128 + m * 16) * ld;
#pragma unroll
                for (int bj = 0; bj < 2; ++bj) { *(f32x4*)(rowp + bj * 128) = acc[ai][bj][m][0]; *(f32x4*)(rowp + bj * 128 + 4) = acc[ai][bj][m][1]; }
                if (m & 1) asm volatile("" ::: "memory"); }
    }
};

struct EpiSW {
    static constexpr bool PERM = false, AFTER_DRAIN = false;
    float* out; int ld, coff;
    __device__ __forceinline__ void operator()(const f32x4 (&acc)[2][2][4][2], const Unit& u, int wr, int wc, int fr_, int fq_) const {
        const int tl_ = opaque_tid(); const int fr = tl_ & 15, fq = (tl_ >> 4) & 3; (void)fr_; (void)fq_;
        if (u.pm == 0 && wr == 0 && fr < 9) {
#pragma unroll
            for (int bj = 0; bj < 2; ++bj)
#pragma unroll
                for (int n = 0; n < 2; ++n) *(f32x4*)(out + (size_t)fr * ld + coff + u.pn * 256 + bj * 128 + wc * 32 + 16 * n + 4 * fq) = acc[0][bj][0][n];
        }
    }
};

template <class Epi>
__device__ __forceinline__ void run_gemm(LAS unsigned char* lds, const bf16_t* A, const bf16_t* Bt, int M, int N, int K, int rot, const Epi& E, int ld = 0) {
    pg8::Gemm g{A, Bt, M, N, K, ld ? ld : K}; pg8::StaticOrder S; const int G = opaque_G();
    int c = (int)blockIdx.x - rot; if (c < 0) c += G; if (c < 0) c += G;
    S.init(M, N, G, c);
    pg8::gemm_phase<Epi, pg8::StaticOrder, true, true>(lds, g, S, E);
}

__device__ __forceinline__ void transpose_item(const float* W, int ldw, int k0, int n0, bf16_t* dst, int ldd, LAS float* scr, int lane) {
    {
        f32x4 wv[8]; const int c4 = 4 * (lane & 7), kr = lane >> 3;
#pragma unroll
        for (int i = 0; i < 8; ++i) wv[i] = *(const f32x4*)(W + (size_t)(k0 + 8 * i + kr) * ldw + n0 + c4);
#pragma unroll
        for (int i = 0; i < 8; ++i) { LAS float* d = scr + (8 * i + kr) * 33 + c4; d[0] = wv[i][0]; d[1] = wv[i][1]; d[2] = wv[i][2]; d[3] = wv[i][3]; }
    }
    asm volatile("s_waitcnt lgkmcnt(0)" ::: "memory");
    const int c = lane & 7;
#pragma unroll
    for (int j = 0; j < 4; ++j) { const int n = (lane >> 3) + 8 * j; const LAS float* s = scr + (8 * c) * 33 + n;
        u32x4 o; o.x = pk2(s[0 * 33], s[1 * 33]); o.y = pk2(s[2 * 33], s[3 * 33]); o.z = pk2(s[4 * 33], s[5 * 33]); o.w = pk2(s[6 * 33], s[7 * 33]);
        *(u32x4*)(dst + (size_t)n * ldd + k0 + 8 * c) = o; }
    asm volatile("s_waitcnt lgkmcnt(0)" ::: "memory");
}
__device__ __forceinline__ int gu_dst_row(int n0) { const int up = n0 >= DFF, j = up ? n0 - DFF : n0; return (j >> 7) * 256 + up * 128 + (j & 127); }

constexpr int IT_GU = 16 * 172, IT_D = 43 * 32, IT_MIX = 1280, IT_L = 2 * IT_GU + 2 * IT_D + IT_MIX;

__device__ __forceinline__ void p0a(const Params& p, LAS unsigned char* lds) {
    const int tid = opaque_tid(), lane = tid & 63, wid = __builtin_amdgcn_readfirstlane(tid >> 6), G = opaque_G();
    unsigned char* ws = p.ws;
    if (blockIdx.x == 0) { unsigned* bw = (unsigned*)(ws + O_BAR); for (int i = tid; i < XCD_BAR_WORDS; i += NTHR) bw[i] = 0u; }
    {
        LAS float* scT = (LAS float*)lds;
        LAS float* part = (LAS float*)(lds + 49152);
        for (int idx = tid; idx < 9 * 1024; idx += NTHR) { const int mb = idx >> 10, k = idx & 1023; const float v = mb < 8 ? p.in[I_C][mb * 1024 + k] : p.in[I_CCTX][k]; scT[k * 12 + mb] = silu_f(v); }
        __syncthreads();
        float* mods = (float*)(ws + O_MODS);
        for (int it = blockIdx.x; it < 4 * 144; it += G) {
            const int l = it / 144, cb = it % 144, kbase = wid * 128;
            float a[9];
#pragma unroll
            for (int i = 0; i < 9; ++i) a[i] = 0.f;
            const float* wp = p.in[I_WMOD] + ((size_t)l * 1024 + kbase) * 9216 + cb * 64 + lane;
#pragma unroll 16
            for (int kk = 0; kk < 128; ++kk) {
                const float wv = wp[(size_t)kk * 9216]; const LAS float* s = scT + (kbase + kk) * 12;
                const f32x4 s0 = *(const LAS f32x4*)s, s1 = *(const LAS f32x4*)(s + 4); const float s8 = s[8];
                a[0] += s0[0] * wv; a[1] += s0[1] * wv; a[2] += s0[2] * wv; a[3] += s0[3] * wv;
                a[4] += s1[0] * wv; a[5] += s1[1] * wv; a[6] += s1[2] * wv; a[7] += s1[3] * wv; a[8] += s8 * wv;
            }
#pragma unroll
            for (int i = 0; i < 9; ++i) part[(wid * 9 + i) * 64 + lane] = a[i];
            __syncthreads();
            for (int idx = tid; idx < 576; idx += NTHR) { const int mb = idx >> 6, cl = idx & 63; float s = p.in[I_BMOD][l * 9216 + cb * 64 + cl];
#pragma unroll
                for (int w = 0; w < 8; ++w) s += part[(w * 9 + mb) * 64 + cl];
                mods[((size_t)l * 9 + mb) * 9216 + cb * 64 + cl] = s; }
            __syncthreads();
        }
    }
    __syncthreads();
    {
        LAS float* scr = (LAS float*)(lds + wid * 8448);
        const int gw = blockIdx.x * NWAVE + wid, NGW = G * NWAVE;
        for (int it = gw; it < 4 * IT_L; it += NGW) {
            const int l = it / IT_L, j = l >> 1; int r = it % IT_L;
            unsigned char* wl = ws + O_W + (size_t)l * SZ_WL;
            if (r < IT_GU) { const int kb = r / 172, nb = r % 172; transpose_item(p.in[I_WGU1] + (size_t)l * 1024 * 5504, 5504, kb * 64, nb * 32, (bf16_t*)(wl + W_GU1) + (size_t)gu_dst_row(nb * 32) * 1024, 1024, scr, lane); continue; } r -= IT_GU;
            if (r < IT_D) { const int kb = r / 32, nb = r % 32; transpose_item(p.in[I_WD1] + (size_t)l * DFF * 1024, 1024, kb * 64, nb * 32, (bf16_t*)(wl + W_D1) + (size_t)(nb * 32) * HP, HP, scr, lane); continue; } r -= IT_D;
            if (r < IT_GU) { const int kb = r / 172, nb = r % 172; transpose_item(p.in[I_WGU2] + (size_t)l * 1024 * 5504, 5504, kb * 64, nb * 32, (bf16_t*)(wl + W_GU2) + (size_t)gu_dst_row(nb * 32) * 1024, 1024, scr, lane); continue; } r -= IT_GU;
            if (r < IT_D) { const int kb = r / 32, nb = r % 32; transpose_item(p.in[I_WD2] + (size_t)l * DFF * 1024, 1024, kb * 64, nb * 32, (bf16_t*)(wl + W_D2) + (size_t)(nb * 32) * HP, HP, scr, lane); continue; } r -= IT_D;
            bf16_t* wm = (bf16_t*)(wl + W_MIX);
            if ((l & 1) == 0) {
                if (r < 512) { const int kb = r / 32, nb = r % 32; transpose_item(p.in[I_WIN] + (size_t)j * 1024 * 1536 + 512, 1536, kb * 64, nb * 32, wm + (size_t)(nb * 32) * 1024, 1024, scr, lane); }
                else if (r < 1024) { r -= 512; const int kb = r / 32, nb = r % 32; transpose_item(p.in[I_WOUT] + (size_t)j * 1024 * 1024, 1024, kb * 64, nb * 32, wm + (size_t)2 * 1024 * 1024 + (size_t)(nb * 32) * 1024, 1024, scr, lane); }
            } else {
                if (r < 768) { const int kb = r / 48, nb = r % 48; transpose_item(p.in[I_WQKV] + (size_t)j * 1024 * 1536, 1536, kb * 64, nb * 32, wm + (size_t)(nb * 32) * 1024, 1024, scr, lane); }
                else { r -= 768; const int kb = r / 32, nb = r % 32; transpose_item(p.in[I_WO] + (size_t)j * 1024 * 1024, 1024, kb * 64, nb * 32, wm + (size_t)2 * 1024 * 1024 + (size_t)(nb * 32) * 1024, 1024, scr, lane); }
            }
        }
    }
    __syncthreads();
    {
        LAS float* tab = (LAS float*)lds;
        for (int i = tid; i < 128; i += NTHR) tab[i] = cospif((float)i * (1.0f / 64.0f)) * 0.08838834764831845f;
        __syncthreads();
        float* WF = (float*)(ws + O_WF);
        const int gt = blockIdx.x * NTHR + tid, NT = G * NTHR;
        for (int idx = gt; idx < 2 * 1024 * 1024; idx += NT) {
            const int j = idx >> 20, k = (idx >> 10) & 1023, n = idx & 1023, part = n >> 9, g = (n >> 7) & 3, m = n & 127;
            const float* wr_ = p.in[I_WIN] + ((size_t)j * 1024 + k) * 1536 + g * 128; float s = 0.f; const int sh = part ? 96 : 0;
#pragma unroll 8
            for (int c = 0; c < 128; ++c) s += wr_[c] * tab[(c * m + sh) & 127];
            WF[idx] = s;
        }
    }
    {
        const int gt = blockIdx.x * NTHR + tid, NT = G * NTHR;
        unsigned zv = 0u; asm volatile("" : "+v"(zv)); const u32x4 zero4 = (u32x4){zv, zv, zv, zv};
        float* rowss = (float*)(ws + O_ROWSS);
        for (int i = gt; i < 13 * MT; i += NT) rowss[i] = __builtin_bit_cast(float, zv);
        for (int i = gt; i < 4 * 2 * 128 * 128; i += NT) {
            const int ch = i & 127, rr = (i >> 7) & 127, which = (i >> 14) & 1, l = i >> 15;
            bf16_t* base = (bf16_t*)(ws + O_W + (size_t)l * SZ_WL + (which ? W_GU2 : W_GU1));
            const int row = 21 * 256 + (rr >> 6) * 128 + 64 + (rr & 63);
            *(u32x4*)(base + (size_t)row * 1024 + ch * 8) = zero4;
        }
        for (int i = gt; i < 4 * 2 * 1024 * 8; i += NT) {
            const int ch = i & 7, rr = (i >> 3) & 1023, which = (i >> 13) & 1, l = i >> 14;
            bf16_t* base = (bf16_t*)(ws + O_W + (size_t)l * SZ_WL + (which ? W_D2 : W_D1));
            *(u32x4*)(base + (size_t)rr * HP + DFF + ch * 8) = zero4;
        }
        bf16_t* wsb = (bf16_t*)(ws + O_WSB);
        for (int i = gt; i < 2 * 4 * 128 * 128; i += NT) wsb[i] = (bf16_t)f2bf(p.in[I_WS][i]);
    }
}

__device__ __forceinline__ void p0b(const Params& p, LAS unsigned char* lds) {
    const int tid = opaque_tid(), lane = tid & 63, wid = __builtin_amdgcn_readfirstlane(tid >> 6), G = opaque_G();
    unsigned char* ws = p.ws;
    {
        LAS float* scr = (LAS float*)(lds + wid * 8448);
        const int gw = blockIdx.x * NWAVE + wid, NGW = G * NWAVE;
        for (int it = gw; it < 1024; it += NGW) { const int j = it >> 9, r = it & 511, kb = r / 32, nb = r % 32;
            bf16_t* winf = (bf16_t*)(ws + O_W + (size_t)(2 * j) * SZ_WL + W_MIX) + (size_t)1024 * 1024;
            transpose_item((const float*)(ws + O_WF) + (size_t)j * 1024 * 1024, 1024, kb * 64, nb * 32, winf + (size_t)(nb * 32) * 1024, 1024, scr, lane); }
    }
    const int gt = blockIdx.x * NTHR + tid, NT = G * NTHR;
    const float* mods = (const float*)(ws + O_MODS);
    float* GS = (float*)(ws + O_GS); float* GT = (float*)(ws + O_GT); bf16_t* SP = (bf16_t*)(ws + O_SP);
    for (int idx = gt; idx < 12 * 9 * 1024; idx += NT) {
        const int k = idx & 1023, mb = (idx >> 10) % 9, s = idx / 9216, l = s / 3, i = s % 3;
        const float* mrow = mods + ((size_t)l * 9 + mb) * 9216 + (3 * i) * 1024 + k;
        const float shift = mrow[0], scale = mrow[1024], gate = mrow[2048];
        const float g = (i == 0 ? p.in[I_GFFN1] : (i == 1 ? p.in[I_GMIX] : p.in[I_GFFN2]))[l * 1024 + k];
        GS[idx] = g * (1.0f + scale); GT[idx] = (i == 1 ? 1.0f : 0.5f) * gate;
        SP[((size_t)s * 256 + mb) * 1024 + k] = (bf16_t)f2bf(shift);
    }
    bf16_t* DFTC = (bf16_t*)(ws + O_DFTC);
    for (int idx = gt; idx < 256 * 512; idx += NT) { const int k = idx >> 9, np = idx & 511, part = np >> 8, n = np & 255, j = (k * n) & 255;
        float sn, cs; sincospif((float)j * (1.0f / 128.0f), &sn, &cs); DFTC[idx] = (bf16_t)f2bf((part ? -sn : cs) * 0.0625f); }
}

__device__ __forceinline__ void p0c_rows(const Params& p) {
    const int tid = opaque_tid(), lane = tid & 63, wid = tid >> 6, G = opaque_G();
    unsigned char* ws = p.ws; const float* GS = (const float*)(ws + O_GS); float* rowss = (float*)(ws + O_ROWSS); bf16_t* XG = (bf16_t*)(ws + O_XG);
    for (int r = blockIdx.x * NWAVE + wid; r < MT; r += G * NWAVE) {
        const float* src = r < ML ? p.in[I_X] + (size_t)r * 1024 : p.in[I_CTX] + (size_t)(r - ML) * 1024;
        const int mb = r < ML ? (r >> 12) : 8; float s = 0.f;
#pragma unroll
        for (int j = 0; j < 2; ++j) { const int c = 512 * j + 8 * lane; const f32x4 v0 = *(const f32x4*)(src + c), v1 = *(const f32x4*)(src + c + 4), g0 = *(const f32x4*)(GS + mb * 1024 + c), g1 = *(const f32x4*)(GS + mb * 1024 + c + 4);
            s += ((v0[0] * v0[0] + v0[1] * v0[1]) + (v0[2] * v0[2] + v0[3] * v0[3])) + ((v1[0] * v1[0] + v1[1] * v1[1]) + (v1[2] * v1[2] + v1[3] * v1[3]));
            const f32x4 x0 = v0 * g0, x1 = v1 * g1; u32x4 w; w.x = pk2(x0[0], x0[1]); w.y = pk2(x0[2], x0[3]); w.z = pk2(x1[0], x1[1]); w.w = pk2(x1[2], x1[3]); *(u32x4*)(XG + (size_t)r * 1024 + c) = w; }
#pragma unroll
        for (int o = 1; o < 64; o <<= 1) s += __shfl_xor(s, o);
        if (lane == 0) rowss[r] = s;
    }
}

__device__ __forceinline__ void ctx_fixup(unsigned char* ws, const float* slab, const float* gate, const float* gsn, float* rowss_next, const float* xin) {
    const int tid = opaque_tid(), lane = tid & 63, wid = tid >> 6, G = opaque_G();
    float* XC = (float*)(ws + O_XC); bf16_t* XG = (bf16_t*)(ws + O_XG);
    for (int r = blockIdx.x * NWAVE + wid; r < MC; r += G * NWAVE) {
        float s = 0.f;
#pragma unroll
        for (int j = 0; j < 4; ++j) { const int c = 256 * j + 4 * lane; const size_t o = (size_t)r * 1024 + c;
            const f32x4 p0 = *(const f32x4*)(slab + o), p1 = *(const f32x4*)(slab + (size_t)MC * 1024 + o), p2 = *(const f32x4*)(slab + (size_t)2 * MC * 1024 + o), p3 = *(const f32x4*)(slab + (size_t)3 * MC * 1024 + o);
            const f32x4 gv = *(const f32x4*)(gate + 8 * 1024 + c); const f32x4 xn = *(const f32x4*)(xin + o) + gv * ((p0 + p1) + (p2 + p3));
            *(f32x4*)(XC + o) = xn; s += (xn[0] * xn[0] + xn[1] * xn[1]) + (xn[2] * xn[2] + xn[3] * xn[3]);
            if (gsn) { const f32x4 xs = xn * *(const f32x4*)(gsn + 8 * 1024 + c); u32x2 w; w.x = pk2(xs[0], xs[1]); w.y = pk2(xs[2], xs[3]); *(u32x2*)(XG + (size_t)(ML + r) * 1024 + c) = w; } }
#pragma unroll
        for (int o = 1; o < 64; o <<= 1) s += __shfl_xor(s, o);
        if (lane == 0) rowss_next[ML + r] = s;
    }
}

__device__ __forceinline__ void gen_dft(unsigned char* ws, LAS unsigned char* lds) {
    const int tid = opaque_tid(), G = opaque_G();
    LAS float* tab = (LAS float*)lds;
    __syncthreads();
    for (int i = tid; i < 4096; i += NTHR) tab[i] = cospif((float)i * (1.0f / 2048.0f)) * (1.0f / 64.0f);
    __syncthreads();
    bf16_t* DFT = (bf16_t*)(ws + O_DFT);
    for (int k = blockIdx.x; k < 2048; k += G)
        for (int c8 = tid; c8 < 1024; c8 += NTHR) { const int n0 = c8 * 8, part = n0 >> 12, n = n0 & 4095, sh = part ? 1024 : 0;
            float v[8];
#pragma unroll
            for (int e = 0; e < 8; ++e) v[e] = tab[(k * (n + e) + sh) & 4095];
            u32x4 w; w.x = pk2(v[0], v[1]); w.y = pk2(v[2], v[3]); w.z = pk2(v[4], v[5]); w.w = pk2(v[6], v[7]);
            *(u32x4*)(DFT + (size_t)k * 8192 + n0) = w; }
    __syncthreads();
}

__device__ __forceinline__ void dft_combine(unsigned char* ws, const float* P, const float* Rm) {
    const int tid = opaque_tid(), lane = tid & 63, wid = tid >> 6, G = opaque_G();
    bf16_t* Y = (bf16_t*)(ws + O_MIXA); const bf16_t* FT = (const bf16_t*)(ws + O_FT);
    const int gt = blockIdx.x * NTHR + tid, NT = G * NTHR;
    for (int idx = gt; idx < 2048 * 512; idx += NT) {
        const int k = idx >> 9, j = (idx & 511) * 8, b = j >> 9, c = j & 511; const size_t o = (size_t)k * 4096 + j;
        const f32x4 p0 = *(const f32x4*)(P + o), p1 = *(const f32x4*)(P + o + 4), r0 = *(const f32x4*)(Rm + o), r1 = *(const f32x4*)(Rm + o + 4);
        { const f32x4 a0 = p0 + r0, a1 = p1 + r1; u32x4 w; w.x = pk2(a0[0], a0[1]); w.y = pk2(a0[2], a0[3]); w.z = pk2(a1[0], a1[1]); w.w = pk2(a1[2], a1[3]);
          *(u32x4*)(Y + (size_t)(b * SEQ + k) * 1024 + c) = w; }
        if (k) { const f32x4 a0 = p0 - r0, a1 = p1 - r1; u32x4 w; w.x = pk2(a0[0], a0[1]); w.y = pk2(a0[2], a0[3]); w.z = pk2(a1[0], a1[1]); w.w = pk2(a1[2], a1[3]);
          *(u32x4*)(Y + (size_t)(b * SEQ + 4096 - k) * 1024 + c) = w; }
    }
    for (int j = blockIdx.x * NWAVE + wid; j < 4096; j += G * NWAVE) {
        const bf16_t* src = FT + (size_t)j * 8192 + lane * 64; float sacc = 0.f;
#pragma unroll
        for (int q = 0; q < 8; ++q) { const u32x4 w = *(const u32x4*)(src + 8 * q);
#pragma unroll
            for (int e = 0; e < 4; ++e) sacc += __builtin_bit_cast(float, w[e] << 16) - __builtin_bit_cast(float, w[e] & 0xffff0000u); }
#pragma unroll
        for (int o = 1; o < 64; o <<= 1) sacc += __shfl_xor(sacc, o);
        if (lane == 0) Y[(size_t)((j >> 9) * SEQ + 2048) * 1024 + (j & 511)] = (bf16_t)f2bf(sacc * (1.0f / 64.0f));
    }
}

__device__ __forceinline__ int crow16(int r, int hi) { return (r & 3) + 8 * (r >> 2) + 4 * hi; }

__device__ __forceinline__ void sgu_item(LAS unsigned char* lds, int it, const bf16_t* UV, bf16_t* MixA, const bf16_t* wsb, const float* gv, const float* bs) {
    const int tid = opaque_tid(), lane = tid & 63, wid = tid >> 6, chunk = it >> 2, h = it & 3, tok0 = chunk * 128;
    LAS bf16_t* vT = (LAS bf16_t*)lds;
    LAS bf16_t* wL = (LAS bf16_t*)(lds + 128 * 136 * 2);
    {
        const int q = tid >> 2, d0 = (tid & 3) * 32; const bf16_t* src = UV + (size_t)(tok0 + q) * 1024 + 512 + h * 128 + d0;
        float v[32]; float ss = 0.f;
#pragma unroll
        for (int i = 0; i < 4; ++i) { const u32x4 w = *(const u32x4*)(src + 8 * i);
#pragma unroll
            for (int e = 0; e < 4; ++e) { v[8 * i + 2 * e] = __builtin_bit_cast(float, w[e] << 16); v[8 * i + 2 * e + 1] = __builtin_bit_cast(float, w[e] & 0xffff0000u); } }
#pragma unroll
        for (int e = 0; e < 32; ++e) ss += v[e] * v[e];
        ss += __shfl_xor(ss, 1); ss += __shfl_xor(ss, 2);
        const float rs = __builtin_amdgcn_rsqf(ss * (1.0f / 128.0f) + EPS);
#pragma unroll
        for (int e = 0; e < 32; ++e) vT[(d0 + e) * 136 + q] = (bf16_t)f2bf(v[e] * rs * gv[h * 128 + d0 + e]);
#pragma unroll
        for (int i = 0; i < 4; ++i) { const int idx = tid + NTHR * i, pp = idx >> 4, seg = idx & 15;
            *(LAS u32x4*)(wL + pp * 136 + seg * 8) = *(const u32x4*)(wsb + (size_t)h * 16384 + pp * 128 + seg * 8); }
    }
    __syncthreads();
    const int tp = wid >> 1, tdb = (wid & 1) * 2, r32 = lane & 31, hi = lane >> 5;
    f32x16 a0 = {}, a1 = {};
#pragma unroll
    for (int kk = 0; kk < 8; ++kk) {
        const bf16x8 a = *(const LAS bf16x8*)(wL + (tp * 32 + r32) * 136 + kk * 16 + hi * 8);
        const bf16x8 b0 = *(const LAS bf16x8*)(vT + (tdb * 32 + r32) * 136 + kk * 16 + hi * 8);
        const bf16x8 b1 = *(const LAS bf16x8*)(vT + ((tdb + 1) * 32 + r32) * 136 + kk * 16 + hi * 8);
        a0 = __builtin_amdgcn_mfma_f32_32x32x16_bf16(a, b0, a0, 0, 0, 0);
        a1 = __builtin_amdgcn_mfma_f32_32x32x16_bf16(a, b1, a1, 0, 0, 0);
    }
    __syncthreads();
    LAS float* Mt = (LAS float*)lds;
#pragma unroll
    for (int r = 0; r < 16; ++r) {
        const int pp = tp * 32 + crow16(r, hi); const float bsv = bs[h * 128 + pp];
        Mt[pp * 132 + tdb * 32 + r32] = a0[r] + bsv; Mt[pp * 132 + (tdb + 1) * 32 + r32] = a1[r] + bsv;
    }
    __syncthreads();
    {
        const int pp = tid >> 2, c0 = (tid & 3) * 32; const size_t rowoff = (size_t)(tok0 + pp) * 1024 + h * 128 + c0;
        u32x4 uw[4];
#pragma unroll
        for (int i = 0; i < 4; ++i) uw[i] = *(const u32x4*)(UV + rowoff + 8 * i);
#pragma unroll
        for (int i = 0; i < 4; ++i) {
            const f32x4 m0 = *(const LAS f32x4*)(Mt + pp * 132 + c0 + 8 * i), m1 = *(const LAS f32x4*)(Mt + pp * 132 + c0 + 8 * i + 4);
            u32x4 w;
            w.x = pk2(__builtin_bit_cast(float, uw[i].x << 16) * m0[0], __builtin_bit_cast(float, uw[i].x & 0xffff0000u) * m0[1]);
            w.y = pk2(__builtin_bit_cast(float, uw[i].y << 16) * m0[2], __builtin_bit_cast(float, uw[i].y & 0xffff0000u) * m0[3]);
            w.z = pk2(__builtin_bit_cast(float, uw[i].z << 16) * m1[0], __builtin_bit_cast(float, uw[i].z & 0xffff0000u) * m1[1]);
            w.w = pk2(__builtin_bit_cast(float, uw[i].w << 16) * m1[2], __builtin_bit_cast(float, uw[i].w & 0xffff0000u) * m1[3]);
            *(u32x4*)(MixA + rowoff + 512 + 8 * i) = w;
        }
    }
    __syncthreads();
}

__device__ __forceinline__ void qknorm_phase(const Params& p, int j) {
    const int tid = opaque_tid(), lane = tid & 63, wid = tid >> 6, G = opaque_G(), sub = lane >> 4, jl = lane & 15;
    unsigned char* ws = p.ws; const bf16_t* qk = (const bf16_t*)(ws + O_QKRAW); bf16_t* Qb = (bf16_t*)(ws + O_MIXA); bf16_t* Kb = (bf16_t*)(ws + O_KB);
    const float* gq = p.in[I_GQ] + j * 128 + 8 * jl; const float* gk = p.in[I_GK] + j * 128 + 8 * jl;
    const f32x4 gq0 = *(const f32x4*)gq, gq1 = *(const f32x4*)(gq + 4), gk0 = *(const f32x4*)gk, gk1 = *(const f32x4*)(gk + 4);
    const int half = jl >> 3, x2 = (jl >> 2) & 1;
    float inv[8];
#pragma unroll
    for (int e = 0; e < 8; ++e) inv[e] = __builtin_amdgcn_exp2f(-(float)(8 * (jl & 3) + e) * 0.41524101186092029f);
    const int nitems = MT * 10;
    for (int st = blockIdx.x * NWAVE + wid; st < nitems / 32; st += G * NWAVE) {
        u32x4 raw[8];
#pragma unroll
        for (int u = 0; u < 8; ++u) { const int it = st * 32 + u * 4 + sub; raw[u] = *(const u32x4*)(qk + (size_t)it * 128 + 8 * jl); }
#pragma unroll
        for (int u = 0; u < 8; ++u) {
            const int it = st * 32 + u * 4 + sub, t = it / 10, hh = it % 10;
            float y[8]; float ss = 0.f;
#pragma unroll
            for (int w = 0; w < 4; ++w) { y[2 * w] = __builtin_bit_cast(float, raw[u][w] << 16); y[2 * w + 1] = __builtin_bit_cast(float, raw[u][w] & 0xffff0000u); }
#pragma unroll
            for (int e = 0; e < 8; ++e) ss += y[e] * y[e];
            ss += __shfl_xor(ss, 1); ss += __shfl_xor(ss, 2); ss += __shfl_xor(ss, 4); ss += __shfl_xor(ss, 8);
            const float rs = __builtin_amdgcn_rsqf(ss * (1.0f / 128.0f) + EPS);
            const f32x4 g0 = hh < 8 ? gq0 : gk0, g1 = hh < 8 ? gq1 : gk1;
#pragma unroll
            for (int e = 0; e < 4; ++e) { y[e] *= rs * g0[e]; y[4 + e] *= rs * g1[e]; }
            if (t < ML) { const int n = t & 4095; const float pos = half ? (float)(n & 63) : (float)(n >> 6);
#pragma unroll
                for (int e = 0; e < 8; ++e) { const float ang = pos * inv[e], sn = __sinf(ang), cs = __cosf(ang), pv = __shfl_xor(y[e], 4);
                    y[e] = x2 ? y[e] * cs + pv * sn : y[e] * cs - pv * sn; } }
            u32x4 w; w.x = pk2(y[0], y[1]); w.y = pk2(y[2], y[3]); w.z = pk2(y[4], y[5]); w.w = pk2(y[6], y[7]);
            bf16_t* dst;
            if (hh < 8) dst = Qb + (size_t)t * 1024 + hh * 128;
            else { int b, key; if (t < ML) { b = t >> 12; key = t & 4095; } else { b = (t - ML) >> 8; key = SEQ + ((t - ML) & 255); }
                dst = Kb + ((size_t)(b * 2 + (hh - 8)) * KEYS + key) * 128; }
            *(u32x4*)(dst + 8 * jl) = w;
        }
    }
}

__device__ __forceinline__ void attn_phase(const Params& p, unsigned char* lds_generic, bool with_ctx) {
    unsigned char* ws = p.ws; unsigned short* Q = (unsigned short*)(ws + O_MIXA);
    const attn::bf16* Kb = (const attn::bf16*)(ws + O_KB); const attn::bf16* Vb = (const attn::bf16*)(ws + O_VB);
    const int nunits = with_ctx ? 1024 + 64 : 1024;
    for (int i = blockIdx.x; i < nunits; i += opaque_G()) {
        size_t qoff, koff; int seq;
        if (i < 1024) { const int qb = i & 15, h = (i >> 4) & 7, b = i >> 7; qoff = ((size_t)(b * SEQ + qb * 256)) * 1024 + h * 128; koff = (size_t)(b * 2 + (h >> 2)) * KEYS * 128; seq = KEYS; }
        else { const int jj = i - 1024, h = jj & 7, b = jj >> 3; qoff = ((size_t)(ML + b * NCTX)) * 1024 + h * 128; koff = ((size_t)(b * 2 + (h >> 2)) * KEYS + SEQ) * 128; seq = NCTX; }
        attn::attn_dense_body<attn::bf16>((const attn::bf16*)(Q + qoff), Kb + koff, Vb + koff, (unsigned short*)(ws + O_H) + qoff, seq, (char*)lds_generic);
        __syncthreads();
    }
}

__device__ __forceinline__ void final_phase(const Params& p) {
    const int tid = opaque_tid(), lane = tid & 63, wid = tid >> 6, G = opaque_G();
    const float* rowss = (const float*)(p.ws + O_ROWSS) + (size_t)12 * MT; const float* g = p.in[I_GFINAL];
    for (int r = blockIdx.x * NWAVE + wid; r < ML; r += G * NWAVE) {
        const float rs = rstd_of(rowss[r]); float* row = p.out + (size_t)r * 1024;
#pragma unroll
        for (int j = 0; j < 4; ++j) { const int c = 256 * j + 4 * lane; const f32x4 v = *(const f32x4*)(row + c), gg = *(const f32x4*)(g + c); *(f32x4*)(row + c) = v * rs * gg; }
    }
}

#ifndef MK_REPEAT
#define MK_REPEAT 0
#endif
#ifndef MK_MASK
#define MK_MASK 0xFFFF
#endif
#define EN(k) (((MK_MASK) >> (k)) & 1)
enum { K_P0A = 0, K_P0B, K_P0C, K_GU, K_RES, K_INEV, K_MIXEV, K_QKV, K_QKN, K_ATT, K_FINAL };
constexpr int NSTAGE = 3 + 30 + 1;

__device__ __forceinline__ void decode_stage(int s, int& kind, int& l, int& sub) {
    l = 0; sub = 0;
    if (s < 3) { kind = s; return; }
    if (s == NSTAGE - 1) { kind = K_FINAL; return; }
    const int t = s - 3, pair = t / 15, r = t % 15;
    if (r < 7) { l = 2 * pair;
        switch (r) { case 0: kind = K_GU; sub = 0; break; case 1: kind = K_RES; sub = 0; break; case 2: kind = K_INEV; break; case 3: kind = K_MIXEV; break;
                     case 4: kind = K_RES; sub = 1; break; case 5: kind = K_GU; sub = 2; break; default: kind = K_RES; sub = 2; break; } }
    else { l = 2 * pair + 1;
        switch (r - 7) { case 0: kind = K_GU; sub = 0; break; case 1: kind = K_RES; sub = 0; break; case 2: kind = K_QKV; break; case 3: kind = K_QKN; break; case 4: kind = K_ATT; break;
                         case 5: kind = K_RES; sub = 1; break; case 6: kind = K_GU; sub = 2; break; default: kind = K_RES; sub = 2; break; } }
}

__global__ void __launch_bounds__(NTHR, 2) mk_fwd(Params p) {
    extern __shared__ __attribute__((aligned(16))) unsigned char lds_raw[];
    LAS unsigned char* lds = (LAS unsigned char*)lds_raw;
    cg::grid_group grid = cg::this_grid();
    unsigned char* ws = p.ws;
    float* rowss = (float*)(ws + O_ROWSS);
    bf16_t* XG = (bf16_t*)(ws + O_XG); bf16_t* MIXA = (bf16_t*)(ws + O_MIXA); bf16_t* HB = (bf16_t*)(ws + O_H);
    float* XC = (float*)(ws + O_XC);

    volatile LAS unsigned* bst = (volatile LAS unsigned*)(lds + 131072 + 1024);
    if (threadIdx.x == 0) { bst[0] = 0u; bst[1] = 0u; }
    __syncthreads();
    XcdBarrier xbar; xbar.bar = (unsigned*)(ws + O_BAR); xbar.x = 0; xbar.st = bst;
    for (int s = p.st_lo; s < p.st_hi; ++s) {
        int kind, l, sub; decode_stage(s, kind, l, sub);
        const int j = l >> 1; const bool lastl = (l == 3);
        unsigned char* wl = ws + O_W + (size_t)l * SZ_WL;
        for (int rep = 0; rep < 1 + (((MK_REPEAT) >> kind) & 1); ++rep)
        switch (kind) {
        case K_P0A: if (EN(0)) p0a(p, lds); break;
        case K_P0B: if (EN(1)) p0b(p, lds); break;
        case K_P0C: if (EN(2)) {
            p0c_rows(p);
            int start = 0;
            for (int q = 0; q < 16; ++q) {
                const int ll = q >> 2, w = q & 3; unsigned char* wq = ws + O_W + (size_t)ll * SZ_WL; const bool ev = (ll & 1) == 0;
                int site, N, coff; const bf16_t* Bt;
                if (w == 0) { site = ll * 3; N = NGU; coff = 0; Bt = (const bf16_t*)(wq + W_GU1); }
                else if (w == 1) { site = ll * 3 + 2; N = NGU; coff = 0; Bt = (const bf16_t*)(wq + W_GU2); }
                else if (w == 2) { site = ll * 3 + 1; N = ev ? 1024 : 1536; coff = 0; Bt = (const bf16_t*)(wq + W_MIX); }
                else { if (!ev) continue; site = ll * 3 + 1; N = 1024; coff = 1024; Bt = (const bf16_t*)(wq + W_MIX) + (size_t)1024 * 1024; }
                EpiSW E{(float*)(ws + O_SW) + (size_t)site * 9 * NGU, NGU, coff};
                run_gemm<EpiSW>(lds, (const bf16_t*)(ws + O_SP) + (size_t)site * 256 * 1024, Bt, 256, N, 1024, start, E);
                start += N / 256;
            }
        } break;
        case K_GU: if (EN(3)) {
            const int site = l * 3 + sub; const int M = (lastl && sub == 2) ? ML : MT;
            EpiGU E{HB, rowss + (size_t)site * MT, (const float*)(ws + O_SW) + (size_t)site * 9 * NGU};
            run_gemm<EpiGU>(lds, XG, (const bf16_t*)(wl + (sub == 0 ? W_GU1 : W_GU2)), M, NGU, 1024, 0, E);
            if (l == 0 && sub == 0) gen_dft(ws, lds);
        } break;
        case K_RES: if (EN(4)) {
            const int gsite = l * 3 + sub, nsite = gsite + 1; const bool fin = (nsite == 12);
            const int M = (lastl && sub >= 1) ? ML : MT;
            const bf16_t* A = (sub == 1 && (l & 1) == 0) ? MIXA : HB; const int K = sub == 1 ? 1024 : HP;
            const bf16_t* Bt = (const bf16_t*)(wl + (sub == 0 ? W_D1 : (sub == 2 ? W_D2 : W_MIX + 2 * SZ_WM)));
            EpiRes E{p.out, XC, (const float*)(ws + O_GT) + (size_t)gsite * 9 * 1024, fin ? nullptr : (const float*)(ws + O_GS) + (size_t)nsite * 9 * 1024, XG, rowss + (size_t)nsite * MT,
                     gsite == 0 ? p.in[I_X] : (const float*)p.out, gsite == 0 ? p.in[I_CTX] : (const float*)XC};
            const bool split = (sub != 1 && M == MT);
            run_gemm<EpiRes>(lds, A, Bt, split ? ML : M, 1024, K, 0, E);
            if (split) {
                float* slab = (float*)(ws + O_MIXA);
                for (int q = 0; q < 4; ++q) { const int k0 = (q >> 1) * 1408 + (q & 1) * 640, len = (q & 1) ? 768 : 640;
                    EpiPart EP{slab + (size_t)q * MC * 1024, 1024};
                    run_gemm<EpiPart>(lds, A + (size_t)ML * HP + k0, Bt + k0, MC, 1024, len, 64 * q, EP, HP); }
                xcd_barrier(xbar);
                ctx_fixup(ws, slab, E.gate, E.gsn, E.rowss_next, E.xic);
            }
        } break;
        case K_INEV: if (EN(5)) {
            const int site = l * 3 + 1; const float* sw = (const float*)(ws + O_SW) + (size_t)site * 9 * NGU;
            EpiUV E1{(bf16_t*)(ws + O_UV), rowss + (size_t)site * MT, sw};
            run_gemm<EpiUV>(lds, XG, (const bf16_t*)(wl + W_MIX), MT, 1024, 1024, 0, E1);
            EpiFT E2{(bf16_t*)(ws + O_FT), (bf16_t*)(ws + O_FTC), rowss + (size_t)site * MT, sw + 1024};
            run_gemm<EpiFT>(lds, (const bf16_t*)(wl + W_MIX + SZ_WM), XG, 1024, MT, 1024, (MT / 256 * 4) % 256, E2);
        } break;
        case K_MIXEV: if (EN(6)) {
            float* slabP = (float*)(ws + O_XG); float* slabR = slabP + (size_t)2048 * 4096;
            { EpiPart EP{slabP, 4096}; run_gemm<EpiPart>(lds, (const bf16_t*)(ws + O_DFT), (const bf16_t*)(ws + O_FT), 2048, 4096, 4096, 0, EP, 8192); }
            { EpiPart ER{slabR, 4096}; run_gemm<EpiPart>(lds, (const bf16_t*)(ws + O_DFT) + 4096, (const bf16_t*)(ws + O_FT) + 4096, 2048, 4096, 4096, 128, ER, 8192); }
            if (!lastl) { EpiDFT E2{MIXA, NCTX, ML};
                run_gemm<EpiDFT>(lds, (const bf16_t*)(ws + O_DFTC), (const bf16_t*)(ws + O_FTC), 256, 4096, 512, 0, E2); }
            const int nit = 4 * (MT / 128);
            for (int it = blockIdx.x; it < nit; it += opaque_G())
                sgu_item(lds, it, (const bf16_t*)(ws + O_UV), MIXA, (const bf16_t*)(ws + O_WSB) + (size_t)j * 4 * 16384, p.in[I_GV] + j * 512, p.in[I_BS] + j * 512);
            xcd_barrier(xbar);
            dft_combine(ws, slabP, slabR);
        } break;
        case K_QKV: if (EN(7)) {
            const int site = l * 3 + 1;
            EpiQKV E{(bf16_t*)(ws + O_QKRAW), (bf16_t*)(ws + O_VB), rowss + (size_t)site * MT, (const float*)(ws + O_SW) + (size_t)site * 9 * NGU};
            run_gemm<EpiQKV>(lds, XG, (const bf16_t*)(wl + W_MIX), MT, 1536, 1024, 0, E);
        } break;
        case K_QKN: if (EN(8)) qknorm_phase(p, j); break;
        case K_ATT: if (EN(9)) attn_phase(p, lds_raw, !lastl); break;
        default: if (EN(10)) final_phase(p); break;
        }
        if (s + 1 < p.st_hi) { if (s == p.st_lo) { grid.sync(); xbar = xcd_barrier_post((unsigned*)(ws + O_BAR), bst); } else xcd_barrier(xbar); }
    }
}

#ifndef MK_MULTI
#define MK_MULTI 0
#endif
extern "C" void kernel_launch(void* const* d_in, const int* in_sizes, int n_in, void* d_out, int out_size, void* d_ws, size_t ws_size, hipStream_t stream) {
    static int grid = 0;
    if (grid == 0) {
        if (n_in != 23 || out_size != ML * 1024 || ws_size < WS_END) { fprintf(stderr, "kernel_launch: unexpected shapes (n_in %d out %d ws %zu need %zu)\n", n_in, out_size, ws_size, (size_t)WS_END); grid = -1; return; }
        int dev = 0, cus = 0, per_cu = 0;
        hipGetDevice(&dev); hipDeviceGetAttribute(&cus, hipDeviceAttributeMultiprocessorCount, dev);
        if (hipFuncSetAttribute((const void*)mk_fwd, hipFuncAttributeMaxDynamicSharedMemorySize, LDS_BYTES) != hipSuccess) { fprintf(stderr, "kernel_launch: hipFuncSetAttribute failed\n"); grid = -1; return; }
        hipOccupancyMaxActiveBlocksPerMultiprocessor(&per_cu, (const void*)mk_fwd, NTHR, LDS_BYTES);
        if (per_cu < 1) { fprintf(stderr, "kernel_launch: occupancy query says %d\n", per_cu); per_cu = 1; }
        grid = cus * 1;
        fprintf(stderr, "kernel_launch: grid %d (cus %d, per_cu %d)\n", grid, cus, per_cu);
    }
    if (grid < 0) return;
    Params p{};
    for (int i = 0; i < 23; ++i) p.in[i] = (const float*)d_in[i];
    p.out = (float*)d_out; p.ws = (unsigned char*)d_ws;
#if MK_MULTI
    for (int s = 0; s < NSTAGE; ++s) { p.st_lo = s; p.st_hi = s + 1; void* args[] = {&p};
        hipError_t e = hipLaunchCooperativeKernel((const void*)mk_fwd, dim3(grid), dim3(NTHR), args, LDS_BYTES, stream);
        if (e != hipSuccess) { fprintf(stderr, "launch %d failed: %s\n", s, hipGetErrorString(e)); break; } }
#else
    p.st_lo = 0; p.st_hi = NSTAGE; void* args[] = {&p};
    hipError_t e = hipLaunchCooperativeKernel((const void*)mk_fwd, dim3(grid), dim3(NTHR), args, LDS_BYTES, stream);
    if (e != hipSuccess) fprintf(stderr, "cooperative launch failed: %s (grid %d)\n", hipGetErrorString(e), grid);
#endif
}
```

```cpp
#include <hip/hip_runtime.h>
#include <hip/hip_bf16.h>
#include <hip/hip_cooperative_groups.h>
#include <cstdio>
#include <cstdint>
#include <cmath>
namespace cg = cooperative_groups;
__device__ __forceinline__ int opaque_tid() { int t = (int)threadIdx.x; asm volatile("" : "+v"(t)); return t; }
#define LAS __attribute__((address_space(3)))
__device__ __forceinline__ int opaque_G() { int g = (int)gridDim.x; asm volatile("" : "+s"(g)); return g; }
namespace pg8 {
#define PG8_LAS __attribute__((address_space(3)))
typedef unsigned short bf16_t;
typedef short bf16x8 __attribute__((ext_vector_type(8)));
typedef float f32x4 __attribute__((ext_vector_type(4)));
typedef unsigned u32x4 __attribute__((ext_vector_type(4)));
constexpr int BM = 256, BK = 64, HALF = 128, HTB = HALF * BK * 2  , STAGE_BYTES = 8 * HTB, NXCD = 8, WGM = 4;

__host__ __device__ __forceinline__ int lds_byte(int r, int c) { const int st = (r >> 4) * 2 + (c >> 5), rr = r & 15, cc = c & 31, ob = rr * 64 + cc * 2; return st * 1024 + (ob ^ (((ob >> 9) & 1) << 5)); }
__host__ __device__ __forceinline__ void stage_rc(int b, int& R, int& C) { const int st = b / 1024, sb = b % 1024, swz = sb ^ (((sb >> 9) & 1) << 5); R = (st >> 1) * 16 + swz / 64; C = (st & 1) * 32 + (swz % 64) / 2; }
__host__ __device__ __forceinline__ int perm32(int rho) { const int n = rho >> 4, i = rho & 15; return 8 * (i >> 2) + 4 * n + (i & 3); }

struct Unit { int pm, pn; };
struct Gemm { const bf16_t* A; const bf16_t* Bt; int M, N, K, ld; };

struct StaticOrder {
    int nM, nN, nwg, G, c;
    __host__ __device__ void init(int M, int N, int G_, int c_) { nM = M / BM; nN = N / BM; nwg = nM * nN; G = G_; c = c_; }
    __host__ __device__ bool next(int i, Unit& u) const {
        const long L = (long)i * G + c; if (L >= nwg) return false;
        int wgid = (int)L; { const int q = nwg / NXCD, r = nwg % NXCD, xcd = wgid % NXCD, off = wgid / NXCD; wgid = (xcd < r ? xcd * (q + 1) : r * (q + 1) + (xcd - r) * q) + off; }
        const int nig = WGM * nN, gid = wgid / nig, fm = gid * WGM, gsz = (nM - fm) < WGM ? (nM - fm) : WGM;
        const int rr = wgid % nig;
        if (gsz == 4) { u.pm = fm + (rr & 3); u.pn = rr >> 2; } else if (gsz == 1) { u.pm = fm; u.pn = rr; } else { u.pm = fm + (rr % gsz); u.pn = rr / gsz; }
        return true;
    }
    __device__ __forceinline__ void a_ready(const Unit&) const {}
    __device__ __forceinline__ void done(const Unit&) const {}
};


template <class Epi, class Sched, bool ALIGN_EPI = false, bool SP2 = false>
__device__ __forceinline__ void gemm_phase(PG8_LAS unsigned char* lds, const Gemm g, const Sched& S, const Epi& E) {
    const int tid = ::opaque_tid(), wid = __builtin_amdgcn_readfirstlane(tid >> 6), lane = tid & 63, wr = wid >> 2, wc = wid & 3, fr = lane & 15, fq = lane >> 4;
    const int K = g.K, nt = K / BK, LD = g.ld;
    unsigned voffA[2], voffB[2];
#pragma unroll
    for (int i = 0; i < 2; ++i) { int R, C; stage_rc(tid * 16 + i * 8192, R, C); const int Rb = Epi::PERM ? ((R & ~31) + perm32(R & 31)) : R;
        voffA[i] = (unsigned)(R * LD + C) * 2u; voffB[i] = (unsigned)(Rb * LD + C) * 2u; }
    const size_t kstep = (size_t)(BK * 2);
    const size_t hstep = (size_t)HALF * LD * 2;
    const size_t tstep = 2 * hstep;
    const unsigned ldsw = (unsigned)wid * 1024u;
    const int aoff = lds_byte(wr * 64 + fr, fq * 8), boff = lds_byte(wc * 32 + fr, fq * 8);
#define PG8_SA(b, h) (((b) * 2 + (h)) * HTB)
#define PG8_SB(b, h) ((4 + (b) * 2 + (h)) * HTB)
#define PG8_STAGE(bufoff, gbase, voff) do { _Pragma("unroll") for (int _i = 0; _i < 2; ++_i) \
        __builtin_amdgcn_global_load_lds((const unsigned*)((const char*)(gbase) + (voff)[_i]), (PG8_LAS unsigned*)(lds + (bufoff) + ldsw + _i * 8192), 16, 0, 0); } while (0)
#define PG8_LDA(dst, b, h) do { _Pragma("unroll") for (int m = 0; m < 4; ++m) _Pragma("unroll") for (int k = 0; k < 2; ++k) dst[m][k] = *(const PG8_LAS bf16x8*)(lds + PG8_SA(b, h) + aoff + m * 2048 + k * 1024); } while (0)
#define PG8_LDB(dst, b, h) do { _Pragma("unroll") for (int n = 0; n < 2; ++n) _Pragma("unroll") for (int k = 0; k < 2; ++k) dst[n][k] = *(const PG8_LAS bf16x8*)(lds + PG8_SB(b, h) + boff + n * 2048 + k * 1024); } while (0)
#define PG8_MMA(ai, bj, At, Bt) do { __builtin_amdgcn_s_setprio(1); _Pragma("unroll") for (int m = 0; m < 4; ++m) _Pragma("unroll") for (int n = 0; n < 2; ++n) _Pragma("unroll") for (int k = 0; k < 2; ++k) \
        acc[ai][bj][m][n] = __builtin_amdgcn_mfma_f32_16x16x32_bf16(Bt[n][k], At[m][k], acc[ai][bj][m][n], 0, 0, 0); __builtin_amdgcn_s_setprio(0); } while (0)
#define PG8_WAIT_V(n) asm volatile("s_waitcnt vmcnt(" #n ")" ::: "memory")
#define PG8_WAIT_L(n) asm volatile("s_waitcnt lgkmcnt(" #n ")" ::: "memory")
#define PG8_BAR __builtin_amdgcn_s_barrier()
#define PG8_SCHED __builtin_amdgcn_sched_barrier(0)
    Unit cur, nxt; int ui = 0;
    if (!S.next(0, cur)) return;
    f32x4 acc[2][2][4][2];
#pragma unroll
    for (int a = 0; a < 2; ++a)
#pragma unroll
        for (int b = 0; b < 2; ++b)
#pragma unroll
            for (int m = 0; m < 4; ++m)
#pragma unroll
                for (int n = 0; n < 2; ++n) acc[a][b][m][n] = (f32x4){0.f, 0.f, 0.f, 0.f};
    bf16x8 At[4][2], B0[2][2], B1[2][2];
    const char* cA = (const char*)g.A + (size_t)cur.pm * tstep; const char* cB = (const char*)g.Bt + (size_t)cur.pn * tstep;
    S.a_ready(cur);
    if constexpr (SP2) {
        PG8_STAGE(PG8_SB(0, 0), cB, voffB); PG8_STAGE(PG8_SB(0, 1), cB + hstep, voffB); PG8_STAGE(PG8_SA(0, 0), cA, voffA); PG8_STAGE(PG8_SA(0, 1), cA + hstep, voffA);
        if (wr == 1) PG8_BAR;
        PG8_WAIT_V(2); PG8_BAR;
        PG8_STAGE(PG8_SB(1, 0), cB + kstep, voffB); PG8_STAGE(PG8_SA(1, 0), cA + kstep, voffA); PG8_STAGE(PG8_SB(1, 1), cB + hstep + kstep, voffB);
        PG8_WAIT_V(6); PG8_BAR;
    } else {
        PG8_STAGE(PG8_SB(0, 0), cB, voffB); PG8_STAGE(PG8_SA(0, 0), cA, voffA); PG8_STAGE(PG8_SB(0, 1), cB + hstep, voffB); PG8_STAGE(PG8_SA(0, 1), cA + hstep, voffA);
        if (wr == 1) PG8_BAR;
        PG8_WAIT_V(4); PG8_BAR;
        PG8_STAGE(PG8_SB(1, 0), cB + kstep, voffB); PG8_STAGE(PG8_SA(1, 0), cA + kstep, voffA); PG8_STAGE(PG8_SB(1, 1), cB + hstep + kstep, voffB);
        PG8_WAIT_V(6); PG8_BAR;
    }
    for (;;) {
        const bool has_next = S.next(ui + 1, nxt);
        const char* nA = has_next ? (const char*)g.A + (size_t)nxt.pm * tstep : cA; const char* nB = has_next ? (const char*)g.Bt + (size_t)nxt.pn * tstep : cB;
        for (int t = 0; t < nt; t += 2) {
            const bool last = (t == nt - 2);
            const char* a1 = cA + (size_t)(t + 1) * kstep;
            const char* a2 = last ? nA : cA + (size_t)(t + 2) * kstep; const char* b2 = last ? nB : cB + (size_t)(t + 2) * kstep;
            const char* a3 = a2 + kstep; const char* b3 = b2 + kstep;
            if (last && has_next) S.a_ready(nxt);
            if constexpr (SP2) {
            PG8_LDB(B0, 0, 0); PG8_LDB(B1, 0, 1); PG8_SCHED; PG8_LDA(At, 0, 0); PG8_STAGE(PG8_SA(1, 1), a1 + hstep, voffA);
            PG8_WAIT_V(8); PG8_WAIT_L(0); PG8_BAR; PG8_MMA(0, 0, At, B0); PG8_MMA(0, 1, At, B1); PG8_BAR; PG8_SCHED;
            PG8_LDA(At, 0, 1); PG8_STAGE(PG8_SB(0, 0), b2, voffB); PG8_STAGE(PG8_SB(0, 1), b2 + hstep, voffB); PG8_STAGE(PG8_SA(0, 0), a2, voffA);
            PG8_WAIT_V(8); PG8_WAIT_L(0); PG8_BAR; PG8_MMA(1, 0, At, B0); PG8_MMA(1, 1, At, B1); PG8_BAR; PG8_SCHED;
            PG8_LDB(B0, 1, 0); PG8_LDB(B1, 1, 1); PG8_SCHED; PG8_LDA(At, 1, 0); PG8_STAGE(PG8_SA(0, 1), a2 + hstep, voffA);
            PG8_WAIT_V(8); PG8_WAIT_L(0); PG8_BAR; PG8_MMA(0, 0, At, B0); PG8_MMA(0, 1, At, B1); PG8_BAR; PG8_SCHED;
            PG8_LDA(At, 1, 1); PG8_STAGE(PG8_SB(1, 0), b3, voffB); PG8_STAGE(PG8_SB(1, 1), b3 + hstep, voffB); PG8_STAGE(PG8_SA(1, 0), a3, voffA);
            PG8_WAIT_V(8); PG8_WAIT_L(0); PG8_BAR; PG8_MMA(1, 0, At, B0); PG8_MMA(1, 1, At, B1); PG8_BAR; PG8_SCHED;
            } else {
            PG8_LDB(B0, 0, 0); PG8_SCHED; PG8_LDA(At, 0, 0); PG8_STAGE(PG8_SA(1, 1), a1 + hstep, voffA);
            PG8_WAIT_L(8); PG8_BAR; PG8_WAIT_L(0); PG8_MMA(0, 0, At, B0); PG8_BAR; PG8_SCHED;
            PG8_LDB(B1, 0, 1); PG8_STAGE(PG8_SB(0, 0), b2, voffB);
            PG8_BAR; PG8_WAIT_L(0); PG8_MMA(0, 1, At, B1); PG8_BAR;
            PG8_LDA(At, 0, 1); PG8_STAGE(PG8_SA(0, 0), a2, voffA);
            PG8_BAR; PG8_WAIT_L(0); PG8_MMA(1, 0, At, B0); PG8_BAR; PG8_SCHED;
            PG8_STAGE(PG8_SB(0, 1), b2 + hstep, voffB);
            PG8_WAIT_V(6); PG8_BAR; PG8_MMA(1, 1, At, B1); PG8_BAR;
            PG8_LDB(B0, 1, 0); PG8_SCHED; PG8_LDA(At, 1, 0); PG8_STAGE(PG8_SA(0, 1), a2 + hstep, voffA);
            PG8_WAIT_L(8); PG8_BAR; PG8_WAIT_L(0); PG8_MMA(0, 0, At, B0); PG8_BAR; PG8_SCHED;
            PG8_LDB(B1, 1, 1); PG8_STAGE(PG8_SB(1, 0), b3, voffB);
            PG8_BAR; PG8_WAIT_L(0); PG8_MMA(0, 1, At, B1); PG8_BAR;
            PG8_LDA(At, 1, 1); PG8_STAGE(PG8_SA(1, 0), a3, voffA);
            PG8_BAR; PG8_WAIT_L(0); PG8_MMA(1, 0, At, B0); PG8_BAR; PG8_SCHED;
            PG8_STAGE(PG8_SB(1, 1), b3 + hstep, voffB);
            PG8_WAIT_V(6); PG8_BAR; PG8_MMA(1, 1, At, B1); PG8_BAR;
            }
        }
        if constexpr (ALIGN_EPI) { if (wr == 0) PG8_BAR; }
        if constexpr (!Epi::AFTER_DRAIN) { E(acc, cur, wr, wc, fr, fq); S.done(cur); }
        if (!has_next) break;
#pragma unroll
        for (int a = 0; a < 2; ++a)
#pragma unroll
            for (int b = 0; b < 2; ++b)
#pragma unroll
                for (int m = 0; m < 4; ++m)
#pragma unroll
                    for (int n = 0; n < 2; ++n) acc[a][b][m][n] = (f32x4){0.f, 0.f, 0.f, 0.f};
        cur = nxt; cA = nA; cB = nB; ++ui;
        if constexpr (ALIGN_EPI) { if (wr == 1) PG8_BAR; }
    }
    PG8_WAIT_V(0);
    if constexpr (!ALIGN_EPI) { if (wr == 0) PG8_BAR; }
    PG8_BAR;
    if constexpr (Epi::AFTER_DRAIN) { E.fused(acc, cur, wr, wc, fr, fq, lds, wid, lane); S.done(cur); }
#undef PG8_SA
#undef PG8_SB
#undef PG8_STAGE
#undef PG8_LDA
#undef PG8_LDB
#undef PG8_MMA
#undef PG8_WAIT_V
#undef PG8_WAIT_L
#undef PG8_BAR
#undef PG8_SCHED
}
}
namespace attn {
using bf16 = __hip_bfloat16;
constexpr int   D = 128, NW = 8, QBLK = 32, KVBLK = 64;
constexpr float SCALE = 0.088388347648318440f;
constexpr float THR = 8.f;
constexpr int SDEPTH = 2;
constexpr int LDQ = 1024, LDK = 128, LDO = 1024;
constexpr size_t SHM_V = KVBLK * D * 2, SHM_K = KVBLK * D * 2, SHM_ATTN = 2 * SHM_V + 2 * SHM_K + NW * 64 * 4;
__device__ __forceinline__ unsigned f2bf_rne(float f) { unsigned u = __builtin_bit_cast(unsigned, f); return (u + 0x7fffu + ((u >> 16) & 1u)) >> 16; }
using bf16x8 = __attribute__((ext_vector_type(8))) short;
using s16x4  = __attribute__((ext_vector_type(4))) short;
using f32x16 = __attribute__((ext_vector_type(16))) float;
using f32x8  = __attribute__((ext_vector_type(8))) float;
using u32x4  = __attribute__((ext_vector_type(4))) unsigned;
#define KSWZ(row, colB) ((row) * 256 + ((colB) ^ (((row) & 7) << 4)))
#define SBAR() __builtin_amdgcn_sched_barrier(0)
__device__ __forceinline__ int crow(int r, int hi) { return (r & 3) + 8 * (r >> 2) + 4 * hi; }
__device__ __forceinline__ unsigned cvtpk(float lo, float hi) {
  unsigned r; asm volatile("v_cvt_pk_bf16_f32 %0, %1, %2" : "=v"(r) : "v"(lo), "v"(hi)); return r;
}
template <typename TIn> struct Stage;
template <> struct Stage<bf16>  { using T = bf16x8;
  __device__ static __forceinline__ T ld8(const bf16* p) { return *reinterpret_cast<const bf16x8*>(p); }
  __device__ static __forceinline__ bf16x8 tobf(T x) { return x; } };
template <> struct Stage<float> { using T = f32x8;
  __device__ static __forceinline__ T ld8(const float* p) { return *reinterpret_cast<const f32x8*>(p); }
  __device__ static __forceinline__ bf16x8 tobf(T x) {
    u32x4 w = {cvtpk(x[0], x[1]), cvtpk(x[2], x[3]), cvtpk(x[4], x[5]), cvtpk(x[6], x[7])}; return *reinterpret_cast<bf16x8*>(&w); } };

__device__ __forceinline__ void partialSM(f32x16& p0, f32x16& p1, float& m_reg, float& mn, float& alpha) {
  constexpr float C = SCALE * 1.4426950408889634f;
  float pmax = p0[0]; for (int r = 1; r < 16; ++r) pmax = fmaxf(pmax, p0[r]); for (int r = 0; r < 16; ++r) pmax = fmaxf(pmax, p1[r]);
  { auto rr = __builtin_amdgcn_permlane32_swap(__float_as_uint(pmax), __float_as_uint(pmax), false, false);
    pmax = fmaxf(__uint_as_float(rr[0]), __uint_as_float(rr[1])); }
  if (__builtin_expect(__all(pmax - m_reg <= THR / SCALE), 1)) { mn = m_reg; alpha = 1.f; }
  else { mn = fmaxf(m_reg, pmax); alpha = __builtin_amdgcn_exp2f((m_reg - mn) * C); m_reg = mn; }
  float mnC = -mn * C;
  for (int r = 0; r < 16; ++r) p0[r] = fmaf(p0[r], C, mnC); for (int r = 0; r < 16; ++r) p1[r] = fmaf(p1[r], C, mnC);
  for (int r = 0; r < 16; ++r) p0[r] = __builtin_amdgcn_exp2f(p0[r]);
}
__device__ __forceinline__ void finishSM(f32x16& p0, f32x16& p1, float alpha, float& l_reg, bf16x8& pa0, bf16x8& pa1, bf16x8& pa2, bf16x8& pa3) {
  for (int r = 0; r < 16; ++r) p1[r] = __builtin_amdgcn_exp2f(p1[r]);
  float ps = 0; for (int r = 0; r < 16; ++r) ps += p0[r]; for (int r = 0; r < 16; ++r) ps += p1[r];
  { auto rr = __builtin_amdgcn_permlane32_swap(__float_as_uint(ps), __float_as_uint(ps), false, false);
    ps = __uint_as_float(rr[0]) + __uint_as_float(rr[1]); }
  l_reg = l_reg * alpha + ps;
#define PK4(P, BASE, OUT) do { unsigned a0 = cvtpk(P[BASE + 0], P[BASE + 1]), a1 = cvtpk(P[BASE + 2], P[BASE + 3]);   \
    unsigned b0 = cvtpk(P[BASE + 4], P[BASE + 5]), b1 = cvtpk(P[BASE + 6], P[BASE + 7]);                              \
    auto r0 = __builtin_amdgcn_permlane32_swap(a0, b0, false, false); auto r1 = __builtin_amdgcn_permlane32_swap(a1, b1, false, false); \
    u32x4 w = {r0[0], r1[0], r0[1], r1[1]}; OUT = *reinterpret_cast<bf16x8*>(&w); } while (0)
  PK4(p0, 0, pa0); PK4(p0, 8, pa1); PK4(p1, 0, pa2); PK4(p1, 8, pa3);
#undef PK4
}
__device__ __forceinline__ void qkt(f32x16& p0, f32x16& p1, const bf16* Ks, const bf16x8* qr, int r32, int hi) {
  p0 = f32x16{}; p1 = f32x16{};
  for (int d0 = 0; d0 < 8; ++d0) { int cb = (d0 * 16 + hi * 8) * 2;
    bf16x8 b0 = *reinterpret_cast<const bf16x8*>((const char*)Ks + KSWZ(r32, cb));
    bf16x8 b1 = *reinterpret_cast<const bf16x8*>((const char*)Ks + KSWZ(32 + r32, cb));
    p0 = __builtin_amdgcn_mfma_f32_32x32x16_bf16(b0, qr[d0], p0, 0, 0, 0);
    p1 = __builtin_amdgcn_mfma_f32_32x32x16_bf16(b1, qr[d0], p1, 0, 0, 0); }
}
__device__ __forceinline__ int v_st(int k, int c) { const int kk = (k & ~0xC) | ((k & 4) << 1) | ((k & 8) >> 1); return ((kk >> 3) * 4 + (c >> 5)) * 512 + ((kk & 7) * 32 + (c & 31)) * 2; }
__device__ __forceinline__ int v_rd_base(int lane) { return ((lane & 3) << 3) | (((lane >> 2) & 3) << 6) | (((lane >> 4) & 1) << 5) | (((lane >> 5) & 1) << 8); }
constexpr int v_rd_off(int d0, int ks, int half) { return d0 * 512 + ks * 4096 + half * 2048; }
template <int OFF> __device__ __forceinline__ s16x4 tr_read(int vb) {
  s16x4 r; asm volatile("ds_read_b64_tr_b16 %0, %1 offset:%2" : "=&v"(r) : "v"(vb), "i"(OFF) : "memory"); return r;
}
template <int D0> __device__ __forceinline__ void pv_one(f32x16& od, int vb, bf16x8 pa0, bf16x8 pa1, bf16x8 pa2, bf16x8 pa3) {
  const s16x4 l0 = tr_read<v_rd_off(D0, 0, 0)>(vb), h0 = tr_read<v_rd_off(D0, 0, 1)>(vb), l1 = tr_read<v_rd_off(D0, 1, 0)>(vb), h1 = tr_read<v_rd_off(D0, 1, 1)>(vb);
  const s16x4 l2 = tr_read<v_rd_off(D0, 2, 0)>(vb), h2 = tr_read<v_rd_off(D0, 2, 1)>(vb), l3 = tr_read<v_rd_off(D0, 3, 0)>(vb), h3 = tr_read<v_rd_off(D0, 3, 1)>(vb);
  asm volatile("s_waitcnt lgkmcnt(0)" ::: "memory"); SBAR();
#define PK(L, H) (bf16x8){L[0], L[1], L[2], L[3], H[0], H[1], H[2], H[3]}
  od = __builtin_amdgcn_mfma_f32_32x32x16_bf16(pa0, PK(l0, h0), od, 0, 0, 0);
  od = __builtin_amdgcn_mfma_f32_32x32x16_bf16(pa1, PK(l1, h1), od, 0, 0, 0);
  od = __builtin_amdgcn_mfma_f32_32x32x16_bf16(pa2, PK(l2, h2), od, 0, 0, 0);
  od = __builtin_amdgcn_mfma_f32_32x32x16_bf16(pa3, PK(l3, h3), od, 0, 0, 0);
#undef PK
}
__device__ __forceinline__ void pv_d0(f32x16* o, int vb, bf16x8 pa0, bf16x8 pa1, bf16x8 pa2, bf16x8 pa3) {
  pv_one<0>(o[0], vb, pa0, pa1, pa2, pa3); pv_one<1>(o[1], vb, pa0, pa1, pa2, pa3); pv_one<2>(o[2], vb, pa0, pa1, pa2, pa3); pv_one<3>(o[3], vb, pa0, pa1, pa2, pa3);
}

template <typename TQ>
__device__ __forceinline__ void attn_dense_body(const TQ* __restrict__ Qb, const bf16* __restrict__ Kh, const bf16* __restrict__ Vh,
                                                unsigned short* __restrict__ Ob, int seq, char* lds) {
  using St = Stage<bf16>; using SQ = Stage<TQ>;
  const int tid = ::opaque_tid(), wid = tid >> 6, lane = tid & 63, r32 = lane & 31, hi = lane >> 5;
  bf16* V_lds = (bf16*)lds; bf16* K_lds = (bf16*)(lds + 2 * SHM_V);
  float* ws = (float*)(lds + 2 * SHM_V + 2 * SHM_K) + wid * 64; float* li_l = ws; float* al_l = ws + 32;
  float m_reg = -1e30f, l_reg = 0; f32x16 o[4] = {}; bf16x8 qr[8];
  const TQ* Qw = Qb + (long)(wid * QBLK + r32) * LDQ + hi * 8;
#pragma unroll
  for (int d0 = 0; d0 < 8; ++d0) qr[d0] = SQ::tobf(SQ::ld8(Qw + d0 * 16));
  const int sr = tid >> 4, sc = (tid & 15) * 8, vst0 = v_st(sr, sc), vst1 = v_st(32 + sr, sc);
  const int vb0 = (int)(uintptr_t)V_lds + v_rd_base(lane);
  struct { typename St::T vs0, vs1, ks0, ks1; } sr_[SDEPTH];
#define SLOAD(i, k0) do { sr_[i].vs0 = St::ld8(&Vh[(long)((k0) + sr) * LDK + sc]); sr_[i].vs1 = St::ld8(&Vh[(long)((k0) + 32 + sr) * LDK + sc]); \
    sr_[i].ks0 = St::ld8(&Kh[(long)((k0) + sr) * LDK + sc]); sr_[i].ks1 = St::ld8(&Kh[(long)((k0) + 32 + sr) * LDK + sc]); } while (0)
#define SWRITE(b, i) do { *(bf16x8*)((char*)V_lds + (b) * SHM_V + vst0) = St::tobf(sr_[i].vs0);          \
    *(bf16x8*)((char*)V_lds + (b) * SHM_V + vst1) = St::tobf(sr_[i].vs1); int kc = sc * 2;               \
    *(bf16x8*)((char*)K_lds + (b) * SHM_K + KSWZ(sr, kc)) = St::tobf(sr_[i].ks0);                       \
    *(bf16x8*)((char*)K_lds + (b) * SHM_K + KSWZ(32 + sr, kc)) = St::tobf(sr_[i].ks1); } while (0)
#define SWAIT() do { if constexpr (SDEPTH == 2) asm volatile("s_waitcnt vmcnt(4)" ::: "memory"); else asm volatile("s_waitcnt vmcnt(0)" ::: "memory"); } while (0)
#define RESC(a) do { if (__any((a) < 1.f)) { if (hi == 0) al_l[r32] = (a); asm volatile("s_waitcnt lgkmcnt(0)" ::: "memory"); \
    for (int d = 0; d < 4; ++d) for (int r = 0; r < 16; ++r) o[d][r] *= al_l[crow(r, hi)]; } } while (0)
  f32x16 pA0, pA1, pB0, pB1; float mnA, mnB, alA, alB; bf16x8 pa0, pa1, pa2, pa3; const int NT = seq / KVBLK;
  constexpr int SE = 0, SO = SDEPTH - 1;
  SLOAD(SE, 0); asm volatile("s_waitcnt vmcnt(0)" ::: "memory"); SWRITE(0, SE); __syncthreads();
  qkt(pA0, pA1, K_lds, qr, r32, hi); partialSM(pA0, pA1, m_reg, mnA, alA);
  SLOAD(SO, KVBLK); if constexpr (SDEPTH == 2) { if (2 < NT) SLOAD(SE, 2 * KVBLK); }
  SWAIT(); SWRITE(1, SO); __syncthreads();
  for (int j = 1; j + 1 < NT; j += 2) {
    SBAR(); qkt(pB0, pB1, (bf16*)((char*)K_lds + SHM_K), qr, r32, hi);
    finishSM(pA0, pA1, alA, l_reg, pa0, pa1, pa2, pa3); SBAR();
    SLOAD(SO, (j + SDEPTH) * KVBLK); SBAR();
    pv_d0(o, vb0, pa0, pa1, pa2, pa3); partialSM(pB0, pB1, m_reg, mnB, alB);
    __syncthreads(); SWAIT(); SWRITE(0, SE);
    RESC(alB); __syncthreads();
    SBAR(); qkt(pA0, pA1, K_lds, qr, r32, hi);
    finishSM(pB0, pB1, alB, l_reg, pa0, pa1, pa2, pa3); SBAR();
    if (SDEPTH == 1 || j + 3 < NT) SLOAD(SE, (j + 1 + SDEPTH) * KVBLK); SBAR();
    pv_d0(o, vb0 + (int)SHM_V, pa0, pa1, pa2, pa3); partialSM(pA0, pA1, m_reg, mnA, alA);
    __syncthreads(); SWAIT(); SWRITE(1, SO);
    RESC(alA); __syncthreads();
  }
  SBAR(); qkt(pB0, pB1, (bf16*)((char*)K_lds + SHM_K), qr, r32, hi);
  finishSM(pA0, pA1, alA, l_reg, pa0, pa1, pa2, pa3); SBAR();
  pv_d0(o, vb0, pa0, pa1, pa2, pa3); partialSM(pB0, pB1, m_reg, mnB, alB);
  __syncthreads(); RESC(alB);
  finishSM(pB0, pB1, alB, l_reg, pa0, pa1, pa2, pa3); SBAR();
  pv_d0(o, vb0 + (int)SHM_V, pa0, pa1, pa2, pa3);
  if (hi == 0) li_l[r32] = l_reg; asm volatile("s_waitcnt lgkmcnt(0)" ::: "memory");
  float rli[16];
#pragma unroll
  for (int r = 0; r < 16; ++r) rli[r] = __builtin_amdgcn_rcpf(li_l[crow(r, hi)]);
  __syncthreads();
  unsigned short* Os = (unsigned short*)lds + wid * (32 * 136);
#pragma unroll
  for (int r = 0; r < 16; ++r) { const int orow = crow(r, hi);
#pragma unroll
    for (int d0 = 0; d0 < 4; ++d0) Os[orow * 136 + d0 * 32 + r32] = (unsigned short)f2bf_rne(o[d0][r] * rli[r]); }
  asm volatile("s_waitcnt lgkmcnt(0)" ::: "memory");
  unsigned short* Ow = Ob + (long)(wid * QBLK) * LDO;
#pragma unroll
  for (int i = 0; i < 8; ++i) { const int cidx = lane + 64 * i, row = cidx >> 4, seg = cidx & 15;
    const u32x4 v = *reinterpret_cast<const u32x4*>(Os + row * 136 + seg * 8);
    *reinterpret_cast<u32x4*>(Ow + (long)row * LDO + seg * 8) = v; }
#undef SLOAD
#undef SWRITE
#undef SWAIT
#undef RESC
}

#undef KSWZ
#undef SBAR
}
#define XB_TMO      128
#define XB_XCNT(j)  (256  + 64 * (j))
#define XB_XSUB(j)  (1280 + 64 * (j))
#define XB_XGEN(j)  (2304 + 64 * (j))
#define XB_TOP      3328
#define XB_TOPGEN   3392
#define XCD_BAR_WORDS 3456
#define XB_SPIN_CAP (1u << 18)

__device__ __forceinline__ unsigned xb_ld(unsigned* p)              { return __hip_atomic_load(p, __ATOMIC_RELAXED, __HIP_MEMORY_SCOPE_AGENT); }
__device__ __forceinline__ unsigned xb_add(unsigned* p, unsigned v) { return __hip_atomic_fetch_add(p, v, __ATOMIC_RELAXED, __HIP_MEMORY_SCOPE_AGENT); }
__device__ __forceinline__ unsigned xb_xcc_id() { return (unsigned)__builtin_amdgcn_s_getreg((3 << 11) | 20) & 0xFu; }
#define XB_SPIN(cond, bar) do { unsigned _sp = 0; while (cond) { __builtin_amdgcn_s_sleep(1); \
    if ((++_sp & 255u) == 0u) { if (xb_ld(&(bar)[XB_TMO])) break; if (_sp > XB_SPIN_CAP) { atomicAdd(&(bar)[XB_TMO], 1u); break; } } } } while (0)

struct XcdBarrier {
    unsigned* bar; unsigned x;
    volatile LAS unsigned* st;
};

__device__ __forceinline__ XcdBarrier xcd_barrier_post(unsigned* bar, volatile LAS unsigned* st) {
    XcdBarrier b; b.bar = bar; b.x = xb_xcc_id(); b.st = st;
    if (threadIdx.x == 0) (void)xb_add(&bar[XB_XCNT(b.x)], 1u);
    return b;
}
__device__ __forceinline__ void xcd_barrier_complete(unsigned* bar, unsigned x, unsigned& nloc, unsigned& nx) {
    const unsigned G = gridDim.x * gridDim.y * gridDim.z;
    unsigned sum, cnt, mine, sp = 0u;
    for (;;) {
        sum = 0u; cnt = 0u; mine = 0u;
#pragma unroll
        for (unsigned j = 0; j < 16; ++j) { const unsigned c = xb_ld(&bar[XB_XCNT(j)]); sum += c; cnt += (c > 0u) ? 1u : 0u; mine = (j == x) ? c : mine; }
        if (sum == G) break;
        __builtin_amdgcn_s_sleep(1);
        if ((++sp & 255u) == 0u) { if (xb_ld(&bar[XB_TMO])) break; if (sp > XB_SPIN_CAP) { atomicAdd(&bar[XB_TMO], 1u); break; } }
    }
    nloc = mine > 0u ? mine : 1u; nx = cnt > 0u ? cnt : 1u;
}

__device__ __forceinline__ void xcd_barrier(const XcdBarrier& b) {
    asm volatile("s_waitcnt vmcnt(0)" ::: "memory");
    __syncthreads();
    if (threadIdx.x == 0) {
        unsigned* bar = b.bar;
        __builtin_amdgcn_s_waitcnt(0);
        unsigned nloc = b.st[0], nx = b.st[1];
        if (nloc == 0u) { xcd_barrier_complete(bar, b.x, nloc, nx); b.st[0] = nloc; b.st[1] = nx; }
        const unsigned old = xb_add(&bar[XB_XSUB(b.x)], 1u);
        const unsigned gen = old / nloc;
        if (old + 1u == (gen + 1u) * nloc) {
            __builtin_amdgcn_fence(__ATOMIC_RELEASE, "agent");
            asm volatile("s_waitcnt vmcnt(0)" ::: "memory");
            const unsigned og = xb_add(&bar[XB_TOP], 1u);
            const unsigned tg = og / nx;
            if (og + 1u == (tg + 1u) * nx) xb_add(&bar[XB_TOPGEN], 1u);
            else XB_SPIN(xb_ld(&bar[XB_TOPGEN]) == tg, bar);
            __builtin_amdgcn_fence(__ATOMIC_ACQUIRE, "agent");
            xb_add(&bar[XB_XGEN(b.x)], 1u);
            asm volatile("s_waitcnt vmcnt(0)" ::: "memory");
        } else {
            XB_SPIN(xb_ld(&bar[XB_XGEN(b.x)]) == gen, bar);
            __builtin_amdgcn_fence(__ATOMIC_ACQUIRE, "agent");
            asm volatile("s_waitcnt vmcnt(0)" ::: "memory");
        }
    }
    __syncthreads();
}

using pg8::bf16_t; using pg8::f32x4; using pg8::u32x4; using pg8::bf16x8; using pg8::Unit;
typedef unsigned u32x2 __attribute__((ext_vector_type(2)));
typedef float f32x16 __attribute__((ext_vector_type(16)));

constexpr int DM = 1024, NB = 8, SEQ = 4096, NCTX = 256, ML = NB * SEQ, MC = NB * NCTX, MT = ML + MC;
constexpr int DFF = 2752, HP = 2816, NGU = 2 * HP;
constexpr int KEYS = SEQ + NCTX;
constexpr float EPS = 1e-6f;
constexpr int NTHR = 512, NWAVE = 8;
constexpr int LDS_BYTES = 147456;

constexpr size_t AL(size_t x) { return (x + 255) & ~(size_t)255; }
constexpr size_t O_ROWSS = 0;
constexpr size_t O_BAR   = AL(O_ROWSS + (size_t)13 * MT * 4);
constexpr size_t O_MODS  = AL(O_BAR + (size_t)XCD_BAR_WORDS * 4);
constexpr size_t O_GS    = AL(O_MODS + (size_t)4 * 9 * 9216 * 4);
constexpr size_t O_GT    = AL(O_GS + (size_t)12 * 9 * 1024 * 4);
constexpr size_t O_SW    = AL(O_GT + (size_t)12 * 9 * 1024 * 4);
constexpr size_t O_SP    = AL(O_SW + (size_t)12 * 9 * NGU * 4);
constexpr size_t O_WSB   = AL(O_SP + (size_t)12 * 256 * 1024 * 2);
constexpr size_t O_XC    = AL(O_WSB + (size_t)2 * 4 * 128 * 128 * 2);
constexpr size_t O_XG    = AL(O_XC + (size_t)MC * 1024 * 4);
constexpr size_t O_MIXA  = AL(O_XG + (size_t)MT * 1024 * 2);
constexpr size_t O_H     = AL(O_MIXA + (size_t)MT * 1024 * 2);
constexpr size_t SZ_H    = (size_t)MT * HP * 2;
constexpr size_t O_UV    = O_H;
constexpr size_t O_FT    = AL(O_UV + (size_t)MT * 1024 * 2);
constexpr size_t O_FTC   = AL(O_FT + (size_t)4096 * 8192 * 2);
constexpr size_t O_QKRAW = O_H;
constexpr size_t O_WF    = O_H;
static_assert(O_FTC + (size_t)4096 * 512 * 2 <= O_H + SZ_H, "H overlay");
static_assert((size_t)MT * 1280 * 4 <= SZ_H, "H overlay qk");
constexpr size_t O_DFT   = AL(O_H + SZ_H);
constexpr size_t O_KB    = AL(O_DFT + (size_t)2048 * 8192 * 2);
constexpr size_t O_VB    = AL(O_KB + (size_t)NB * 2 * KEYS * 128 * 2);
constexpr size_t O_DFTC  = AL(O_VB + (size_t)NB * 2 * KEYS * 128 * 2);
constexpr size_t O_W     = AL(O_DFTC + (size_t)256 * 512 * 2);
constexpr size_t SZ_WGU = (size_t)NGU * 1024 * 2, SZ_WD = (size_t)1024 * HP * 2, SZ_WM = (size_t)1024 * 1024 * 2;
constexpr size_t W_GU1 = 0, W_D1 = SZ_WGU, W_GU2 = W_D1 + SZ_WD, W_D2 = W_GU2 + SZ_WGU, W_MIX = W_D2 + SZ_WD;
constexpr size_t SZ_WL = W_MIX + 3 * SZ_WM;
constexpr size_t WS_END = O_W + 4 * SZ_WL;

struct Params { const float* in[23]; float* out; unsigned char* ws; int st_lo, st_hi; };

enum { I_X = 0, I_C, I_CTX, I_CCTX, I_WMOD, I_BMOD, I_GFFN1, I_WGU1, I_WD1, I_GMIX, I_GFFN2, I_WGU2, I_WD2, I_GFINAL, I_WIN, I_GV, I_WS, I_BS, I_WOUT, I_WQKV, I_GQ, I_GK, I_WO };

__device__ __forceinline__ unsigned f2bf(float f) { unsigned u = __builtin_bit_cast(unsigned, f); return (u + 0x7fffu + ((u >> 16) & 1u)) >> 16; }
__device__ __forceinline__ unsigned pk2(float lo, float hi) { unsigned r; asm volatile("v_cvt_pk_bf16_f32 %0, %1, %2" : "=v"(r) : "v"(lo), "v"(hi)); return r; }
__device__ __forceinline__ float bf2f(unsigned short h) { return __builtin_bit_cast(float, (unsigned)h << 16); }
__device__ __forceinline__ float silu_f(float g) { return g * __builtin_amdgcn_rcpf(1.0f + __builtin_amdgcn_exp2f(-1.4426950408889634f * g)); }
__device__ __forceinline__ float gelu_tanh_f(float v) {
    const float z2 = v * (1.5957691216057308f + 0.07135481627159493f * v * v);
    return v * __builtin_amdgcn_rcpf(1.0f + __builtin_amdgcn_exp2f(-1.4426950408889634f * z2));
}
__device__ __forceinline__ int mb_of_panel(int pm) { return pm < 128 ? (pm >> 4) : 8; }
__device__ __forceinline__ float rstd_of(float ss) { return __builtin_amdgcn_rsqf(ss * (1.0f / 1024.0f) + EPS); }

typedef float f32x2v __attribute__((ext_vector_type(2)));
struct EpiGU {
    static constexpr bool PERM = true, AFTER_DRAIN = false;
    bf16_t* H; const float* rowss; const float* sw;
    __device__ __forceinline__ void operator()(const f32x4 (&acc)[2][2][4][2], const Unit& u, int wr, int wc, int fr_, int fq_) const {
        const int tl_ = opaque_tid(); const int fr = tl_ & 15, fq = (tl_ >> 4) & 3; (void)fr_; (void)fq_;
        const int mb = mb_of_panel(u.pm), row0 = u.pm * 256 + wr * 64 + fr, hc0 = u.pn * 128 + wc * 32 + 8 * fq;
        const float* swg = sw + (size_t)mb * NGU + u.pn * 256 + wc * 32 + 8 * fq;
        f32x4 bg[2], bu[2];
#pragma unroll
        for (int n = 0; n < 2; ++n) { bg[n] = *(const f32x4*)(swg + 4 * n); bu[n] = *(const f32x4*)(swg + 128 + 4 * n); }
        float rsv[2][4];
#pragma unroll
        for (int ai = 0; ai < 2; ++ai)
#pragma unroll
            for (int m = 0; m < 4; ++m) rsv[ai][m] = rstd_of(rowss[row0 + ai * 128 + m * 16]);
#pragma unroll
        for (int ai = 0; ai < 2; ++ai)
#pragma unroll
            for (int m = 0; m < 4; ++m) {
                const int r = row0 + ai * 128 + m * 16; const float rs = rsv[ai][m];
                f32x2v g[4], up[4], e[4];
#pragma unroll
                for (int n = 0; n < 2; ++n) { const f32x4 gv = acc[ai][0][m][n] * rs + bg[n], uv = acc[ai][1][m][n] * rs + bu[n];
                    g[2 * n] = (f32x2v){gv[0], gv[1]}; g[2 * n + 1] = (f32x2v){gv[2], gv[3]}; up[2 * n] = (f32x2v){uv[0], uv[1]}; up[2 * n + 1] = (f32x2v){uv[2], uv[3]}; }
#pragma unroll
                for (int q = 0; q < 4; ++q) { const f32x2v t = g[q] * -1.4426950408889634f; e[q].x = __builtin_amdgcn_exp2f(t.x); e[q].y = __builtin_amdgcn_exp2f(t.y); }
#pragma unroll
                for (int q = 0; q < 4; ++q) { const f32x2v d = e[q] + 1.0f; e[q].x = __builtin_amdgcn_rcpf(d.x); e[q].y = __builtin_amdgcn_rcpf(d.y); }
#pragma unroll
                for (int q = 0; q < 4; ++q) g[q] = (g[q] * e[q]) * up[q];
                u32x4 w; w.x = pk2(g[0].x, g[0].y); w.y = pk2(g[1].x, g[1].y); w.z = pk2(g[2].x, g[2].y); w.w = pk2(g[3].x, g[3].y);
                *(u32x4*)(H + (size_t)r * HP + hc0) = w;
            }
    }
};

struct EpiRes {
    static constexpr bool PERM = true, AFTER_DRAIN = false;
    float* xl; float* xc; const float* gate; const float* gsn; bf16_t* xg; float* rowss_next; const float* xil; const float* xic;
    __device__ __forceinline__ void operator()(const f32x4 (&acc)[2][2][4][2], const Unit& u, int wr, int wc, int fr_, int fq_) const {
        const int tl_ = opaque_tid(); const int fr = tl_ & 15, fq = (tl_ >> 4) & 3; (void)fr_; (void)fq_;
        const int mb = mb_of_panel(u.pm);
        float* xb = u.pm < 128 ? xl + (size_t)u.pm * 256 * 1024 : xc + (size_t)(u.pm - 128) * 256 * 1024;
        const float* xib = u.pm < 128 ? xil + (size_t)u.pm * 256 * 1024 : xic + (size_t)(u.pm - 128) * 256 * 1024;
        const int lr0 = wr * 64 + fr, col0 = u.pn * 256 + wc * 32 + 8 * fq;
        float* xbase = xb + (size_t)lr0 * 1024 + col0; const float* xibase = xib + (size_t)lr0 * 1024 + col0;
        bf16_t* gbase = xg + ((size_t)u.pm * 256 + lr0) * 1024 + col0;
        float ss[4];
        f32x4 xa[4][2], xbf[4][2];
#define RES_LOAD(buf, bj, ai) do { _Pragma("unroll") for (int m = 0; m < 4; ++m) { const float* px = xibase + (size_t)((ai) * 128 + m * 16) * 1024 + (bj) * 128; buf[m][0] = *(const f32x4*)px; buf[m][1] = *(const f32x4*)(px + 4); } asm volatile("" ::: "memory"); } while (0)
#define RES_PROC(buf, bj, ai) do { const f32x4 gv0 = *(const f32x4*)(gate + mb * 1024 + col0 + (bj) * 128), gv1 = *(const f32x4*)(gate + mb * 1024 + col0 + (bj) * 128 + 4); \
        f32x4 gs0 = (f32x4){0.f, 0.f, 0.f, 0.f}, gs1 = gs0; if (gsn) { gs0 = *(const f32x4*)(gsn + mb * 1024 + col0 + (bj) * 128); gs1 = *(const f32x4*)(gsn + mb * 1024 + col0 + (bj) * 128 + 4); } \
        _Pragma("unroll") for (int m = 0; m < 4; ++m) { float* px = xbase + (size_t)((ai) * 128 + m * 16) * 1024 + (bj) * 128; \
            const f32x4 xn0 = buf[m][0] + gv0 * acc[ai][bj][m][0], xn1 = buf[m][1] + gv1 * acc[ai][bj][m][1]; \
            *(f32x4*)px = xn0; *(f32x4*)(px + 4) = xn1; \
            const float sq = ((xn0[0] * xn0[0] + xn0[1] * xn0[1]) + (xn0[2] * xn0[2] + xn0[3] * xn0[3])) + ((xn1[0] * xn1[0] + xn1[1] * xn1[1]) + (xn1[2] * xn1[2] + xn1[3] * xn1[3])); \
            ss[m] = (bj) ? ss[m] + sq : sq; \
            if (gsn) { const f32x4 xs0 = xn0 * gs0, xs1 = xn1 * gs1; u32x4 w; w.x = pk2(xs0[0], xs0[1]); w.y = pk2(xs0[2], xs0[3]); w.z = pk2(xs1[0], xs1[1]); w.w = pk2(xs1[2], xs1[3]); \
                *(u32x4*)(gbase + (size_t)((ai) * 128 + m * 16) * 1024 + (bj) * 128) = w; } } asm volatile("" ::: "memory"); } while (0)
#define RES_ATOM(ai) do { _Pragma("unroll") for (int m = 0; m < 4; ++m) { float sv = ss[m]; sv += __shfl_xor(sv, 16); sv += __shfl_xor(sv, 32); \
            if (fq == 0) unsafeAtomicAdd(rowss_next + (size_t)u.pm * 256 + lr0 + (ai) * 128 + m * 16, sv); } } while (0)
        RES_LOAD(xa, 0, 0);
        RES_LOAD(xbf, 1, 0); RES_PROC(xa, 0, 0);
        RES_LOAD(xa, 0, 1); RES_PROC(xbf, 1, 0); RES_ATOM(0);
        RES_LOAD(xbf, 1, 1); RES_PROC(xa, 0, 1);
        RES_PROC(xbf, 1, 1); RES_ATOM(1);
#undef RES_LOAD
#undef RES_PROC
#undef RES_ATOM
    }
};

struct EpiUV {
    static constexpr bool PERM = true, AFTER_DRAIN = false;
    bf16_t* O; const float* rowss; const float* sw;
    __device__ __forceinline__ void operator()(const f32x4 (&acc)[2][2][4][2], const Unit& u, int wr, int wc, int fr_, int fq_) const {
        const int tl_ = opaque_tid(); const int fr = tl_ & 15, fq = (tl_ >> 4) & 3; (void)fr_; (void)fq_;
        const int mb = mb_of_panel(u.pm), row0 = u.pm * 256 + wr * 64 + fr, col0 = u.pn * 256 + wc * 32 + 8 * fq;
        f32x4 bv[2][2];
#pragma unroll
        for (int bj = 0; bj < 2; ++bj)
#pragma unroll
            for (int n = 0; n < 2; ++n) bv[bj][n] = *(const f32x4*)(sw + (size_t)mb * NGU + col0 + bj * 128 + 4 * n);
#pragma unroll
        for (int ai = 0; ai < 2; ++ai)
#pragma unroll
            for (int m = 0; m < 4; ++m) {
                const int r = row0 + ai * 128 + m * 16; const float rs = rstd_of(rowss[r]);
#pragma unroll
                for (int bj = 0; bj < 2; ++bj) {
                    const f32x4 v0 = acc[ai][bj][m][0] * rs + bv[bj][0], v1 = acc[ai][bj][m][1] * rs + bv[bj][1];
                    u32x4 w; w.x = pk2(gelu_tanh_f(v0[0]), gelu_tanh_f(v0[1])); w.y = pk2(gelu_tanh_f(v0[2]), gelu_tanh_f(v0[3]));
                    w.z = pk2(gelu_tanh_f(v1[0]), gelu_tanh_f(v1[1])); w.w = pk2(gelu_tanh_f(v1[2]), gelu_tanh_f(v1[3]));
                    *(u32x4*)(O + (size_t)r * 1024 + col0 + bj * 128) = w;
                }
            }
    }
};

struct EpiFT {
    static constexpr bool PERM = true, AFTER_DRAIN = false;
    bf16_t* FT; bf16_t* FTC; const float* rowss; const float* sw;
    __device__ __forceinline__ void operator()(const f32x4 (&acc)[2][2][4][2], const Unit& u, int wr, int wc, int fr_, int fq_) const {
        const int tl_ = opaque_tid(); const int fr = tl_ & 15, fq = (tl_ >> 4) & 3; (void)fr_; (void)fq_;
        const int mb = mb_of_panel(u.pn), tok0 = u.pn * 256 + wc * 32 + 8 * fq;
        f32x4 rs[2][2];
#pragma unroll
        for (int bj = 0; bj < 2; ++bj)
#pragma unroll
            for (int n = 0; n < 2; ++n) { const f32x4 s = *(const f32x4*)(rowss + tok0 + bj * 128 + 4 * n);
                rs[bj][n] = (f32x4){rstd_of(s[0]), rstd_of(s[1]), rstd_of(s[2]), rstd_of(s[3])}; }
#pragma unroll
        for (int ai = 0; ai < 2; ++ai)
#pragma unroll
            for (int m = 0; m < 4; ++m) {
                const int ch = u.pm * 256 + ai * 128 + wr * 64 + m * 16 + fr, part = ch >> 9, c = ch & 511;
                const float swv = sw[(size_t)mb * NGU + ch];
#pragma unroll
                for (int bj = 0; bj < 2; ++bj) {
                    const f32x4 v0 = acc[ai][bj][m][0] * rs[bj][0] + swv, v1 = acc[ai][bj][m][1] * rs[bj][1] + swv;
                    u32x4 w; w.x = pk2(v0[0], v0[1]); w.y = pk2(v0[2], v0[3]); w.z = pk2(v1[0], v1[1]); w.w = pk2(v1[2], v1[3]);
                    bf16_t* dst;
                    if (u.pn < 128) { const int b = u.pn >> 4, npos = (u.pn & 15) * 256 + bj * 128 + wc * 32 + 8 * fq; dst = FT + ((size_t)(b * 512 + c) * 8192 + part * 4096 + npos); }
                    else { const int b = u.pn - 128, npos = bj * 128 + wc * 32 + 8 * fq; dst = FTC + ((size_t)(b * 512 + c) * 512 + part * 256 + npos); }
                    *(u32x4*)dst = w;
                }
            }
    }
};

struct EpiDFT {
    static constexpr bool PERM = true, AFTER_DRAIN = false;
    bf16_t* O; int rows_per_b, row_base;
    __device__ __forceinline__ void operator()(const f32x4 (&acc)[2][2][4][2], const Unit& u, int wr, int wc, int fr_, int fq_) const {
        const int tl_ = opaque_tid(); const int fr = tl_ & 15, fq = (tl_ >> 4) & 3; (void)fr_; (void)fq_;
        const int b = u.pn >> 1;
        bf16_t* base = O + (size_t)(row_base + b * rows_per_b + u.pm * 256 + wr * 64 + fr) * 1024 + (u.pn & 1) * 256 + wc * 32 + 8 * fq;
#pragma unroll
        for (int ai = 0; ai < 2; ++ai)
#pragma unroll
            for (int m = 0; m < 4; ++m) {
                bf16_t* rowp = base + (size_t)(ai * 128 + m * 16) * 1024;
#pragma unroll
                for (int bj = 0; bj < 2; ++bj) {
                    const f32x4 v0 = acc[ai][bj][m][0], v1 = acc[ai][bj][m][1];
                    u32x4 w; w.x = pk2(v0[0], v0[1]); w.y = pk2(v0[2], v0[3]); w.z = pk2(v1[0], v1[1]); w.w = pk2(v1[2], v1[3]);
                    *(u32x4*)(rowp + bj * 128) = w;
                }
                if (m & 1) asm volatile("" ::: "memory");
            }
    }
};

struct EpiQKV {
    static constexpr bool PERM = false, AFTER_DRAIN = false;
    bf16_t* qk; bf16_t* vb; const float* rowss; const float* sw;
    __device__ __forceinline__ void operator()(const f32x4 (&acc)[2][2][4][2], const Unit& u, int wr, int wc, int fr_, int fq_) const {
        const int tl_ = opaque_tid(); const int fr = tl_ & 15, fq = (tl_ >> 4) & 3; (void)fr_; (void)fq_;
        const int mb = mb_of_panel(u.pm), lr0 = wr * 64 + fr, col0 = u.pn * 256 + wc * 32 + 4 * fq;
        f32x4 bv[2][2];
#pragma unroll
        for (int bj = 0; bj < 2; ++bj)
#pragma unroll
            for (int n = 0; n < 2; ++n) bv[bj][n] = *(const f32x4*)(sw + (size_t)mb * NGU + col0 + bj * 128 + n * 16);
#pragma unroll
        for (int ai = 0; ai < 2; ++ai)
#pragma unroll
            for (int m = 0; m < 4; ++m) {
                const int lr = lr0 + ai * 128 + m * 16, r = u.pm * 256 + lr; const float rs = rstd_of(rowss[r]);
#pragma unroll
                for (int bj = 0; bj < 2; ++bj)
#pragma unroll
                    for (int n = 0; n < 2; ++n) {
                        const f32x4 v = acc[ai][bj][m][n] * rs + bv[bj][n];
                        if (u.pn < 5) { u32x2 w; w.x = pk2(v[0], v[1]); w.y = pk2(v[2], v[3]); *(u32x2*)(qk + (size_t)r * 1280 + col0 + bj * 128 + n * 16) = w; }
                        else { const int d = wc * 32 + 16 * n + 4 * fq; int b, key;
                            if (u.pm < 128) { b = u.pm >> 4; key = (u.pm & 15) * 256 + lr; } else { b = u.pm - 128; key = SEQ + lr; }
                            u32x2 w; w.x = pk2(v[0], v[1]); w.y = pk2(v[2], v[3]);
                            *(u32x2*)(vb + ((size_t)(b * 2 + bj) * KEYS + key) * 128 + d) = w; }
                    }
            }
    }
};

struct EpiPart {
    static constexpr bool PERM = true, AFTER_DRAIN = false;
    float* slab; int ld;
    __device__ __forceinline__ void operator()(const f32x4 (&acc)[2][2][4][2], const Unit& u, int wr, int wc, int fr_, int fq_) const {
        const int tl_ = opaque_tid(); const int fr = tl_ & 15, fq = (tl_ >> 4) & 3; (void)fr_; (void)fq_;
        float* base = slab + (size_t)(u.pm * 256 + wr * 64 + fr) * ld + u.pn * 256 + wc * 32 + 8 * fq;
#pragma unroll
        for (int ai = 0; ai < 2; ++ai)
#pragma unroll
            for (int m = 0; m < 4; ++m) { float* rowp = base + (size_t)(ai * 128 + m * 16) * ld;
#pragma unroll
                for (int bj = 0; bj < 2; ++bj) { *(f32x4*)(rowp + bj * 128) = acc[ai][bj][m][0]; *(f32x4*)(rowp + bj * 128 + 4) = acc[ai][bj][m][1]; }
                if (m & 1) asm volatile("" ::: "memory"); }
    }
};

struct EpiSW {
    static constexpr bool PERM = false, AFTER_DRAIN = false;
    float* out; int ld, coff;
    __device__ __forceinline__ void operator()(const f32x4 (&acc)[2][2][4][2], const Unit& u, int wr, int wc, int fr_, int fq_) const {
        const int tl_ = opaque_tid(); const int fr = tl_ & 15, fq = (tl_ >> 4) & 3; (void)fr_; (void)fq_;
        if (u.pm == 0 && wr == 0 && fr < 9) {
#pragma unroll
            for (int bj = 0; bj < 2; ++bj)
#pragma unroll
                for (int n = 0; n < 2; ++n) *(f32x4*)(out + (size_t)fr * ld + coff + u.pn * 256 + bj * 128 + wc * 32 + 16 * n + 4 * fq) = acc[0][bj][0][n];
        }
    }
};

template <class Epi>
__device__ __forceinline__ void run_gemm(LAS unsigned char* lds, const bf16_t* A, const bf16_t* Bt, int M, int N, int K, int rot, const Epi& E, int ld = 0) {
    pg8::Gemm g{A, Bt, M, N, K, ld ? ld : K}; pg8::StaticOrder S; const int G = opaque_G();
    int c = (int)blockIdx.x - rot; if (c < 0) c += G; if (c < 0) c += G;
    S.init(M, N, G, c);
    pg8::gemm_phase<Epi, pg8::StaticOrder, true, true>(lds, g, S, E);
}

__device__ __forceinline__ void transpose_item(const float* W, int ldw, int k0, int n0, bf16_t* dst, int ldd, LAS float* scr, int lane) {
    {
        f32x4 wv[8]; const int c4 = 4 * (lane & 7), kr = lane >> 3;
#pragma unroll
        for (int i = 0; i < 8; ++i) wv[i] = *(const f32x4*)(W + (size_t)(k0 + 8 * i + kr) * ldw + n0 + c4);
#pragma unroll
        for (int i = 0; i < 8; ++i) { LAS float* d = scr + (8 * i + kr) * 33 + c4; d[0] = wv[i][0]; d[1] = wv[i][1]; d[2] = wv[i][2]; d[3] = wv[i][3]; }
    }
    asm volatile("s_waitcnt lgkmcnt(0)" ::: "memory");
    const int c = lane & 7;
#pragma unroll
    for (int j = 0; j < 4; ++j) { const int n = (lane >> 3) + 8 * j; const LAS float* s = scr + (8 * c) * 33 + n;
        u32x4 o; o.x = pk2(s[0 * 33], s[1 * 33]); o.y = pk2(s[2 * 33], s[3 * 33]); o.z = pk2(s[4 * 33], s[5 * 33]); o.w = pk2(s[6 * 33], s[7 * 33]);
        *(u32x4*)(dst + (size_t)n * ldd + k0 + 8 * c) = o; }
    asm volatile("s_waitcnt lgkmcnt(0)" ::: "memory");
}
__device__ __forceinline__ int gu_dst_row(int n0) { const int up = n0 >= DFF, j = up ? n0 - DFF : n0; return (j >> 7) * 256 + up * 128 + (j & 127); }

constexpr int IT_GU = 16 * 172, IT_D = 43 * 32, IT_MIX = 1280, IT_L = 2 * IT_GU + 2 * IT_D + IT_MIX;

__device__ __forceinline__ void p0a(const Params& p, LAS unsigned char* lds) {
    const int tid = opaque_tid(), lane = tid & 63, wid = __builtin_amdgcn_readfirstlane(tid >> 6), G = opaque_G();
    unsigned char* ws = p.ws;
    if (blockIdx.x == 0) { unsigned* bw = (unsigned*)(ws + O_BAR); for (int i = tid; i < XCD_BAR_WORDS; i += NTHR) bw[i] = 0u; }
    {
        LAS float* scT = (LAS float*)lds;
        LAS float* part = (LAS float*)(lds + 49152);
        for (int idx = tid; idx < 9 * 1024; idx += NTHR) { const int mb = idx >> 10, k = idx & 1023; const float v = mb < 8 ? p.in[I_C][mb * 1024 + k] : p.in[I_CCTX][k]; scT[k * 12 + mb] = silu_f(v); }
        __syncthreads();
        float* mods = (float*)(ws + O_MODS);
        for (int it = blockIdx.x; it < 4 * 144; it += G) {
            const int l = it / 144, cb = it % 144, kbase = wid * 128;
            float a[9];
#pragma unroll
            for (int i = 0; i < 9; ++i) a[i] = 0.f;
            const float* wp = p.in[I_WMOD] + ((size_t)l * 1024 + kbase) * 9216 + cb * 64 + lane;
#pragma unroll 16
            for (int kk = 0; kk < 128; ++kk) {
                const float wv = wp[(size_t)kk * 9216]; const LAS float* s = scT + (kbase + kk) * 12;
                const f32x4 s0 = *(const LAS f32x4*)s, s1 = *(const LAS f32x4*)(s + 4); const float s8 = s[8];
                a[0] += s0[0] * wv; a[1] += s0[1] * wv; a[2] += s0[2] * wv; a[3] += s0[3] * wv;
                a[4] += s1[0] * wv; a[5] += s1[1] * wv; a[6] += s1[2] * wv; a[7] += s1[3] * wv; a[8] += s8 * wv;
            }
#pragma unroll
            for (int i = 0; i < 9; ++i) part[(wid * 9 + i) * 64 + lane] = a[i];
            __syncthreads();
            for (int idx = tid; idx < 576; idx += NTHR) { const int mb = idx >> 6, cl = idx & 63; float s = p.in[I_BMOD][l * 9216 + cb * 64 + cl];
#pragma unroll
                for (int w = 0; w < 8; ++w) s += part[(w * 9 + mb) * 64 + cl];
                mods[((size_t)l * 9 + mb) * 9216 + cb * 64 + cl] = s; }
            __syncthreads();
        }
    }
    __syncthreads();
    {
        LAS float* scr = (LAS float*)(lds + wid * 8448);
        const int gw = blockIdx.x * NWAVE + wid, NGW = G * NWAVE;
        for (int it = gw; it < 4 * IT_L; it += NGW) {
            const int l = it / IT_L, j = l >> 1; int r = it % IT_L;
            unsigned char* wl = ws + O_W + (size_t)l * SZ_WL;
            if (r < IT_GU) { const int kb = r / 172, nb = r % 172; transpose_item(p.in[I_WGU1] + (size_t)l * 1024 * 5504, 5504, kb * 64, nb * 32, (bf16_t*)(wl + W_GU1) + (size_t)gu_dst_row(nb * 32) * 1024, 1024, scr, lane); continue; } r -= IT_GU;
            if (r < IT_D) { const int kb = r / 32, nb = r % 32; transpose_item(p.in[I_WD1] + (size_t)l * DFF * 1024, 1024, kb * 64, nb * 32, (bf16_t*)(wl + W_D1) + (size_t)(nb * 32) * HP, HP, scr, lane); continue; } r -= IT_D;
            if (r < IT_GU) { const int kb = r / 172, nb = r % 172; transpose_item(p.in[I_WGU2] + (size_t)l * 1024 * 5504, 5504, kb * 64, nb * 32, (bf16_t*)(wl + W_GU2) + (size_t)gu_dst_row(nb * 32) * 1024, 1024, scr, lane); continue; } r -= IT_GU;
            if (r < IT_D) { const int kb = r / 32, nb = r % 32; transpose_item(p.in[I_WD2] + (size_t)l * DFF * 1024, 1024, kb * 64, nb * 32, (bf16_t*)(wl + W_D2) + (size_t)(nb * 32) * HP, HP, scr, lane); continue; } r -= IT_D;
            bf16_t* wm = (bf16_t*)(wl + W_MIX);
            if ((l & 1) == 0) {
                if (r < 512) { const int kb = r / 32, nb = r % 32; transpose_item(p.in[I_WIN] + (size_t)j * 1024 * 1536 + 512, 1536, kb * 64, nb * 32, wm + (size_t)(nb * 32) * 1024, 1024, scr, lane); }
                else if (r < 1024) { r -= 512; const int kb = r / 32, nb = r % 32; transpose_item(p.in[I_WOUT] + (size_t)j * 1024 * 1024, 1024, kb * 64, nb * 32, wm + (size_t)2 * 1024 * 1024 + (size_t)(nb * 32) * 1024, 1024, scr, lane); }
            } else {
                if (r < 768) { const int kb = r / 48, nb = r % 48; transpose_item(p.in[I_WQKV] + (size_t)j * 1024 * 1536, 1536, kb * 64, nb * 32, wm + (size_t)(nb * 32) * 1024, 1024, scr, lane); }
                else { r -= 768; const int kb = r / 32, nb = r % 32; transpose_item(p.in[I_WO] + (size_t)j * 1024 * 1024, 1024, kb * 64, nb * 32, wm + (size_t)2 * 1024 * 1024 + (size_t)(nb * 32) * 1024, 1024, scr, lane); }
            }
        }
    }
    __syncthreads();
    {
        LAS float* tab = (LAS float*)lds;
        for (int i = tid; i < 128; i += NTHR) tab[i] = cospif((float)i * (1.0f / 64.0f)) * 0.08838834764831845f;
        __syncthreads();
        float* WF = (float*)(ws + O_WF);
        const int gt = blockIdx.x * NTHR + tid, NT = G * NTHR;
        for (int idx = gt; idx < 2 * 1024 * 1024; idx += NT) {
            const int j = idx >> 20, k = (idx >> 10) & 1023, n = idx & 1023, part = n >> 9, g = (n >> 7) & 3, m = n & 127;
            const float* wr_ = p.in[I_WIN] + ((size_t)j * 1024 + k) * 1536 + g * 128; float s = 0.f; const int sh = part ? 96 : 0;
#pragma unroll 8
            for (int c = 0; c < 128; ++c) s += wr_[c] * tab[(c * m + sh) & 127];
            WF[idx] = s;
        }
    }
    {
        const int gt = blockIdx.x * NTHR + tid, NT = G * NTHR;
        unsigned zv = 0u; asm volatile("" : "+v"(zv)); const u32x4 zero4 = (u32x4){zv, zv, zv, zv};
        float* rowss = (float*)(ws + O_ROWSS);
        for (int i = gt; i < 13 * MT; i += NT) rowss[i] = __builtin_bit_cast(float, zv);
        for (int i = gt; i < 4 * 2 * 128 * 128; i += NT) {
            const int ch = i & 127, rr = (i >> 7) & 127, which = (i >> 14) & 1, l = i >> 15;
            bf16_t* base = (bf16_t*)(ws + O_W + (size_t)l * SZ_WL + (which ? W_GU2 : W_GU1));
            const int row = 21 * 256 + (rr >> 6) * 128 + 64 + (rr & 63);
            *(u32x4*)(base + (size_t)row * 1024 + ch * 8) = zero4;
        }
        for (int i = gt; i < 4 * 2 * 1024 * 8; i += NT) {
            const int ch = i & 7, rr = (i >> 3) & 1023, which = (i >> 13) & 1, l = i >> 14;
            bf16_t* base = (bf16_t*)(ws + O_W + (size_t)l * SZ_WL + (which ? W_D2 : W_D1));
            *(u32x4*)(base + (size_t)rr * HP + DFF + ch * 8) = zero4;
        }
        bf16_t* wsb = (bf16_t*)(ws + O_WSB);
        for (int i = gt; i < 2 * 4 * 128 * 128; i += NT) wsb[i] = (bf16_t)f2bf(p.in[I_WS][i]);
    }
}

__device__ __forceinline__ void p0b(const Params& p, LAS unsigned char* lds) {
    const int tid = opaque_tid(), lane = tid & 63, wid = __builtin_amdgcn_readfirstlane(tid >> 6), G = opaque_G();
    unsigned char* ws = p.ws;
    {
        LAS float* scr = (LAS float*)(lds + wid * 8448);
        const int gw = blockIdx.x * NWAVE + wid, NGW = G * NWAVE;
        for (int it = gw; it < 1024; it += NGW) { const int j = it >> 9, r = it & 511, kb = r / 32, nb = r % 32;
            bf16_t* winf = (bf16_t*)(ws + O_W + (size_t)(2 * j) * SZ_WL + W_MIX) + (size_t)1024 * 1024;
            transpose_item((const float*)(ws + O_WF) + (size_t)j * 1024 * 1024, 1024, kb * 64, nb * 32, winf + (size_t)(nb * 32) * 1024, 1024, scr, lane); }
    }
    const int gt = blockIdx.x * NTHR + tid, NT = G * NTHR;
    const float* mods = (const float*)(ws + O_MODS);
    float* GS = (float*)(ws + O_GS); float* GT = (float*)(ws + O_GT); bf16_t* SP = (bf16_t*)(ws + O_SP);
    for (int idx = gt; idx < 12 * 9 * 1024; idx += NT) {
        const int k = idx & 1023, mb = (idx >> 10) % 9, s = idx / 9216, l = s / 3, i = s % 3;
        const float* mrow = mods + ((size_t)l * 9 + mb) * 9216 + (3 * i) * 1024 + k;
        const float shift = mrow[0], scale = mrow[1024], gate = mrow[2048];
        const float g = (i == 0 ? p.in[I_GFFN1] : (i == 1 ? p.in[I_GMIX] : p.in[I_GFFN2]))[l * 1024 + k];
        GS[idx] = g * (1.0f + scale); GT[idx] = (i == 1 ? 1.0f : 0.5f) * gate;
        SP[((size_t)s * 256 + mb) * 1024 + k] = (bf16_t)f2bf(shift);
    }
    bf16_t* DFTC = (bf16_t*)(ws + O_DFTC);
    for (int idx = gt; idx < 256 * 512; idx += NT) { const int k = idx >> 9, np = idx & 511, part = np >> 8, n = np & 255, j = (k * n) & 255;
        float sn, cs; sincospif((float)j * (1.0f / 128.0f), &sn, &cs); DFTC[idx] = (bf16_t)f2bf((part ? -sn : cs) * 0.0625f); }
}

__device__ __forceinline__ void p0c_rows(const Params& p) {
    const int tid = opaque_tid(), lane = tid & 63, wid = tid >> 6, G = opaque_G();
    unsigned char* ws = p.ws; const float* GS = (const float*)(ws + O_GS); float* rowss = (float*)(ws + O_ROWSS); bf16_t* XG = (bf16_t*)(ws + O_XG);
    for (int r = blockIdx.x * NWAVE + wid; r < MT; r += G * NWAVE) {
        const float* src = r < ML ? p.in[I_X] + (size_t)r * 1024 : p.in[I_CTX] + (size_t)(r - ML) * 1024;
        const int mb = r < ML ? (r >> 12) : 8; float s = 0.f;
#pragma unroll
        for (int j = 0; j < 2; ++j) { const int c = 512 * j + 8 * lane; const f32x4 v0 = *(const f32x4*)(src + c), v1 = *(const f32x4*)(src + c + 4), g0 = *(const f32x4*)(GS + mb * 1024 + c), g1 = *(const f32x4*)(GS + mb * 1024 + c + 4);
            s += ((v0[0] * v0[0] + v0[1] * v0[1]) + (v0[2] * v0[2] + v0[3] * v0[3])) + ((v1[0] * v1[0] + v1[1] * v1[1]) + (v1[2] * v1[2] + v1[3] * v1[3]));
            const f32x4 x0 = v0 * g0, x1 = v1 * g1; u32x4 w; w.x = pk2(x0[0], x0[1]); w.y = pk2(x0[2], x0[3]); w.z = pk2(x1[0], x1[1]); w.w = pk2(x1[2], x1[3]); *(u32x4*)(XG + (size_t)r * 1024 + c) = w; }
#pragma unroll
        for (int o = 1; o < 64; o <<= 1) s += __shfl_xor(s, o);
        if (lane == 0) rowss[r] = s;
    }
}

__device__ __forceinline__ void ctx_fixup(unsigned char* ws, const float* slab, const float* gate, const float* gsn, float* rowss_next, const float* xin) {
    const int tid = opaque_tid(), lane = tid & 63, wid = tid >> 6, G = opaque_G();
    float* XC = (float*)(ws + O_XC); bf16_t* XG = (bf16_t*)(ws + O_XG);
    for (int r = blockIdx.x * NWAVE + wid; r < MC; r += G * NWAVE) {
        float s = 0.f;
#pragma unroll
        for (int j = 0; j < 4; ++j) { const int c = 256 * j + 4 * lane; const size_t o = (size_t)r * 1024 + c;
            const f32x4 p0 = *(const f32x4*)(slab + o), p1 = *(const f32x4*)(slab + (size_t)MC * 1024 + o), p2 = *(const f32x4*)(slab + (size_t)2 * MC * 1024 + o), p3 = *(const f32x4*)(slab + (size_t)3 * MC * 1024 + o);
            const f32x4 gv = *(const f32x4*)(gate + 8 * 1024 + c); const f32x4 xn = *(const f32x4*)(xin + o) + gv * ((p0 + p1) + (p2 + p3));
            *(f32x4*)(XC + o) = xn; s += (xn[0] * xn[0] + xn[1] * xn[1]) + (xn[2] * xn[2] + xn[3] * xn[3]);
            if (gsn) { const f32x4 xs = xn * *(const f32x4*)(gsn + 8 * 1024 + c); u32x2 w; w.x = pk2(xs[0], xs[1]); w.y = pk2(xs[2], xs[3]); *(u32x2*)(XG + (size_t)(ML + r) * 1024 + c) = w; } }
#pragma unroll
        for (int o = 1; o < 64; o <<= 1) s += __shfl_xor(s, o);
        if (lane == 0) rowss_next[ML + r] = s;
    }
}

__device__ __forceinline__ void gen_dft(unsigned char* ws, LAS unsigned char* lds) {
    const int tid = opaque_tid(), G = opaque_G();
    LAS float* tab = (LAS float*)lds;
    __syncthreads();
    for (int i = tid; i < 4096; i += NTHR) tab[i] = cospif((float)i * (1.0f / 2048.0f)) * (1.0f / 64.0f);
    __syncthreads();
    bf16_t* DFT = (bf16_t*)(ws + O_DFT);
    for (int k = blockIdx.x; k < 2048; k += G)
        for (int c8 = tid; c8 < 1024; c8 += NTHR) { const int n0 = c8 * 8, part = n0 >> 12, n = n0 & 4095, sh = part ? 1024 : 0;
            float v[8];
#pragma unroll
            for (int e = 0; e < 8; ++e) v[e] = tab[(k * (n + e) + sh) & 4095];
            u32x4 w; w.x = pk2(v[0], v[1]); w.y = pk2(v[2], v[3]); w.z = pk2(v[4], v[5]); w.w = pk2(v[6], v[7]);
            *(u32x4*)(DFT + (size_t)k * 8192 + n0) = w; }
    __syncthreads();
}

__device__ __forceinline__ void dft_combine(unsigned char* ws, const float* P, const float* Rm) {
    const int tid = opaque_tid(), lane = tid & 63, wid = tid >> 6, G = opaque_G();
    bf16_t* Y = (bf16_t*)(ws + O_MIXA); const bf16_t* FT = (const bf16_t*)(ws + O_FT);
    const int gt = blockIdx.x * NTHR + tid, NT = G * NTHR;
    for (int idx = gt; idx < 2048 * 512; idx += NT) {
        const int k = idx >> 9, j = (idx & 511) * 8, b = j >> 9, c = j & 511; const size_t o = (size_t)k * 4096 + j;
        const f32x4 p0 = *(const f32x4*)(P + o), p1 = *(const f32x4*)(P + o + 4), r0 = *(const f32x4*)(Rm + o), r1 = *(const f32x4*)(Rm + o + 4);
        { const f32x4 a0 = p0 + r0, a1 = p1 + r1; u32x4 w; w.x = pk2(a0[0], a0[1]); w.y = pk2(a0[2], a0[3]); w.z = pk2(a1[0], a1[1]); w.w = pk2(a1[2], a1[3]);
          *(u32x4*)(Y + (size_t)(b * SEQ + k) * 1024 + c) = w; }
        if (k) { const f32x4 a0 = p0 - r0, a1 = p1 - r1; u32x4 w; w.x = pk2(a0[0], a0[1]); w.y = pk2(a0[2], a0[3]); w.z = pk2(a1[0], a1[1]); w.w = pk2(a1[2], a1[3]);
          *(u32x4*)(Y + (size_t)(b * SEQ + 4096 - k) * 1024 + c) = w; }
    }
    for (int j = blockIdx.x * NWAVE + wid; j < 4096; j += G * NWAVE) {
        const bf16_t* src = FT + (size_t)j * 8192 + lane * 64; float sacc = 0.f;
#pragma unroll
        for (int q = 0; q < 8; ++q) { const u32x4 w = *(const u32x4*)(src + 8 * q);
#pragma unroll
            for (int e = 0; e < 4; ++e) sacc += __builtin_bit_cast(float, w[e] << 16) - __builtin_bit_cast(float, w[e] & 0xffff0000u); }
#pragma unroll
        for (int o = 1; o < 64; o <<= 1) sacc += __shfl_xor(sacc, o);
        if (lane == 0) Y[(size_t)((j >> 9) * SEQ + 2048) * 1024 + (j & 511)] = (bf16_t)f2bf(sacc * (1.0f / 64.0f));
    }
}

__device__ __forceinline__ int crow16(int r, int hi) { return (r & 3) + 8 * (r >> 2) + 4 * hi; }

__device__ __forceinline__ void sgu_item(LAS unsigned char* lds, int it, const bf16_t* UV, bf16_t* MixA, const bf16_t* wsb, const float* gv, const float* bs) {
    const int tid = opaque_tid(), lane = tid & 63, wid = tid >> 6, chunk = it >> 2, h = it & 3, tok0 = chunk * 128;
    LAS bf16_t* vT = (LAS bf16_t*)lds;
    LAS bf16_t* wL = (LAS bf16_t*)(lds + 128 * 136 * 2);
    {
        const int q = tid >> 2, d0 = (tid & 3) * 32; const bf16_t* src = UV + (size_t)(tok0 + q) * 1024 + 512 + h * 128 + d0;
        float v[32]; float ss = 0.f;
#pragma unroll
        for (int i = 0; i < 4; ++i) { const u32x4 w = *(const u32x4*)(src + 8 * i);
#pragma unroll
            for (int e = 0; e < 4; ++e) { v[8 * i + 2 * e] = __builtin_bit_cast(float, w[e] << 16); v[8 * i + 2 * e + 1] = __builtin_bit_cast(float, w[e] & 0xffff0000u); } }
#pragma unroll
        for (int e = 0; e < 32; ++e) ss += v[e] * v[e];
        ss += __shfl_xor(ss, 1); ss += __shfl_xor(ss, 2);
        const float rs = 1.0f / sqrtf(ss * (1.0f / 128.0f) + EPS);
#pragma unroll
        for (int e = 0; e < 32; ++e) vT[(d0 + e) * 136 + q] = (bf16_t)f2bf(v[e] * rs * gv[h * 128 + d0 + e]);
#pragma unroll
        for (int i = 0; i < 4; ++i) { const int idx = tid + NTHR * i, pp = idx >> 4, seg = idx & 15;
            *(LAS u32x4*)(wL + pp * 136 + seg * 8) = *(const u32x4*)(wsb + (size_t)h * 16384 + pp * 128 + seg * 8); }
    }
    __syncthreads();
    const int tp = wid >> 1, tdb = (wid & 1) * 2, r32 = lane & 31, hi = lane >> 5;
    f32x16 a0 = {}, a1 = {};
#pragma unroll
    for (int kk = 0; kk < 8; ++kk) {
        const bf16x8 a = *(const LAS bf16x8*)(wL + (tp * 32 + r32) * 136 + kk * 16 + hi * 8);
        const bf16x8 b0 = *(const LAS bf16x8*)(vT + (tdb * 32 + r32) * 136 + kk * 16 + hi * 8);
        const bf16x8 b1 = *(const LAS bf16x8*)(vT + ((tdb + 1) * 32 + r32) * 136 + kk * 16 + hi * 8);
        a0 = __builtin_amdgcn_mfma_f32_32x32x16_bf16(a, b0, a0, 0, 0, 0);
        a1 = __builtin_amdgcn_mfma_f32_32x32x16_bf16(a, b1, a1, 0, 0, 0);
    }
    __syncthreads();
    LAS float* Mt = (LAS float*)lds;
#pragma unroll
    for (int r = 0; r < 16; ++r) {
        const int pp = tp * 32 + crow16(r, hi); const float bsv = bs[h * 128 + pp];
        Mt[pp * 132 + tdb * 32 + r32] = a0[r] + bsv; Mt[pp * 132 + (tdb + 1) * 32 + r32] = a1[r] + bsv;
    }
    __syncthreads();
    {
        const int pp = tid >> 2, c0 = (tid & 3) * 32; const size_t rowoff = (size_t)(tok0 + pp) * 1024 + h * 128 + c0;
        u32x4 uw[4];
#pragma unroll
        for (int i = 0; i < 4; ++i) uw[i] = *(const u32x4*)(UV + rowoff + 8 * i);
#pragma unroll
        for (int i = 0; i < 4; ++i) {
            const f32x4 m0 = *(const LAS f32x4*)(Mt + pp * 132 + c0 + 8 * i), m1 = *(const LAS f32x4*)(Mt + pp * 132 + c0 + 8 * i + 4);
            u32x4 w;
            w.x = pk2(__builtin_bit_cast(float, uw[i].x << 16) * m0[0], __builtin_bit_cast(float, uw[i].x & 0xffff0000u) * m0[1]);
            w.y = pk2(__builtin_bit_cast(float, uw[i].y << 16) * m0[2], __builtin_bit_cast(float, uw[i].y & 0xffff0000u) * m0[3]);
            w.z = pk2(__builtin_bit_cast(float, uw[i].z << 16) * m1[0], __builtin_bit_cast(float, uw[i].z & 0xffff0000u) * m1[1]);
            w.w = pk2(__builtin_bit_cast(float, uw[i].w << 16) * m1[2], __builtin_bit_cast(float, uw[i].w & 0xffff0000u) * m1[3]);
            *(u32x4*)(MixA + rowoff + 512 + 8 * i) = w;
        }
    }
    __syncthreads();
}

__device__ __forceinline__ void qknorm_phase(const Params& p, int j) {
    const int tid = opaque_tid(), lane = tid & 63, wid = tid >> 6, G = opaque_G(), sub = lane >> 4, jl = lane & 15;
    unsigned char* ws = p.ws; const bf16_t* qk = (const bf16_t*)(ws + O_QKRAW); bf16_t* Qb = (bf16_t*)(ws + O_MIXA); bf16_t* Kb = (bf16_t*)(ws + O_KB);
    const float* gq = p.in[I_GQ] + j * 128 + 8 * jl; const float* gk = p.in[I_GK] + j * 128 + 8 * jl;
    const f32x4 gq0 = *(const f32x4*)gq, gq1 = *(const f32x4*)(gq + 4), gk0 = *(const f32x4*)gk, gk1 = *(const f32x4*)(gk + 4);
    const int half = jl >> 3, x2 = (jl >> 2) & 1;
    float inv[8];
#pragma unroll
    for (int e = 0; e < 8; ++e) inv[e] = __builtin_amdgcn_exp2f(-(float)(8 * (jl & 3) + e) * 0.41524101186092029f);
    const int nitems = MT * 10;
    for (int st = blockIdx.x * NWAVE + wid; st < nitems / 32; st += G * NWAVE) {
        u32x4 raw[8];
#pragma unroll
        for (int u = 0; u < 8; ++u) { const int it = st * 32 + u * 4 + sub; raw[u] = *(const u32x4*)(qk + (size_t)it * 128 + 8 * jl); }
#pragma unroll
        for (int u = 0; u < 8; ++u) {
            const int it = st * 32 + u * 4 + sub, t = it / 10, hh = it % 10;
            float y[8]; float ss = 0.f;
#pragma unroll
            for (int w = 0; w < 4; ++w) { y[2 * w] = __builtin_bit_cast(float, raw[u][w] << 16); y[2 * w + 1] = __builtin_bit_cast(float, raw[u][w] & 0xffff0000u); }
#pragma unroll
            for (int e = 0; e < 8; ++e) ss += y[e] * y[e];
            ss += __shfl_xor(ss, 1); ss += __shfl_xor(ss, 2); ss += __shfl_xor(ss, 4); ss += __shfl_xor(ss, 8);
            const float rs = 1.0f / sqrtf(ss * (1.0f / 128.0f) + EPS);
            const f32x4 g0 = hh < 8 ? gq0 : gk0, g1 = hh < 8 ? gq1 : gk1;
#pragma unroll
            for (int e = 0; e < 4; ++e) { y[e] *= rs * g0[e]; y[4 + e] *= rs * g1[e]; }
            if (t < ML) { const int n = t & 4095; const float pos = half ? (float)(n & 63) : (float)(n >> 6);
#pragma unroll
                for (int e = 0; e < 8; ++e) { const float ang = pos * inv[e], sn = __sinf(ang), cs = __cosf(ang), pv = __shfl_xor(y[e], 4);
                    y[e] = x2 ? y[e] * cs + pv * sn : y[e] * cs - pv * sn; } }
            u32x4 w; w.x = pk2(y[0], y[1]); w.y = pk2(y[2], y[3]); w.z = pk2(y[4], y[5]); w.w = pk2(y[6], y[7]);
            bf16_t* dst;
            if (hh < 8) dst = Qb + (size_t)t * 1024 + hh * 128;
            else { int b, key; if (t < ML) { b = t >> 12; key = t & 4095; } else { b = (t - ML) >> 8; key = SEQ + ((t - ML) & 255); }
                dst = Kb + ((size_t)(b * 2 + (hh - 8)) * KEYS + key) * 128; }
            *(u32x4*)(dst + 8 * jl) = w;
        }
    }
}

__device__ __forceinline__ void attn_phase(const Params& p, unsigned char* lds_generic, bool with_ctx) {
    unsigned char* ws = p.ws; unsigned short* Q = (unsigned short*)(ws + O_MIXA);
    const attn::bf16* Kb = (const attn::bf16*)(ws + O_KB); const attn::bf16* Vb = (const attn::bf16*)(ws + O_VB);
    const int nunits = with_ctx ? 1024 + 64 : 1024;
    for (int i = blockIdx.x; i < nunits; i += opaque_G()) {
        size_t qoff, koff; int seq;
        if (i < 1024) { const int qb = i & 15, h = (i >> 4) & 7, b = i >> 7; qoff = ((size_t)(b * SEQ + qb * 256)) * 1024 + h * 128; koff = (size_t)(b * 2 + (h >> 2)) * KEYS * 128; seq = KEYS; }
        else { const int jj = i - 1024, h = jj & 7, b = jj >> 3; qoff = ((size_t)(ML + b * NCTX)) * 1024 + h * 128; koff = ((size_t)(b * 2 + (h >> 2)) * KEYS + SEQ) * 128; seq = NCTX; }
        attn::attn_dense_body<attn::bf16>((const attn::bf16*)(Q + qoff), Kb + koff, Vb + koff, (unsigned short*)(ws + O_H) + qoff, seq, (char*)lds_generic);
        __syncthreads();
    }
}

__device__ __forceinline__ void final_phase(const Params& p) {
    const int tid = opaque_tid(), lane = tid & 63, wid = tid >> 6, G = opaque_G();
    const float* rowss = (const float*)(p.ws + O_ROWSS) + (size_t)12 * MT; const float* g = p.in[I_GFINAL];
    for (int r = blockIdx.x * NWAVE + wid; r < ML; r += G * NWAVE) {
        const float rs = rstd_of(rowss[r]); float* row = p.out + (size_t)r * 1024;
#pragma unroll
        for (int j = 0; j < 4; ++j) { const int c = 256 * j + 4 * lane; const f32x4 v = *(const f32x4*)(row + c), gg = *(const f32x4*)(g + c); *(f32x4*)(row + c) = v * rs * gg; }
    }
}

#ifndef MK_REPEAT
#define MK_REPEAT 0
#endif
#ifndef MK_MASK
#define MK_MASK 0xFFFF
#endif
#define EN(k) (((MK_MASK) >> (k)) & 1)
enum { K_P0A = 0, K_P0B, K_P0C, K_GU, K_RES, K_INEV, K_MIXEV, K_QKV, K_QKN, K_ATT, K_FINAL };
constexpr int NSTAGE = 3 + 30 + 1;

__device__ __forceinline__ void decode_stage(int s, int& kind, int& l, int& sub) {
    l = 0; sub = 0;
    if (s < 3) { kind = s; return; }
    if (s == NSTAGE - 1) { kind = K_FINAL; return; }
    const int t = s - 3, pair = t / 15, r = t % 15;
    if (r < 7) { l = 2 * pair;
        switch (r) { case 0: kind = K_GU; sub = 0; break; case 1: kind = K_RES; sub = 0; break; case 2: kind = K_INEV; break; case 3: kind = K_MIXEV; break;
                     case 4: kind = K_RES; sub = 1; break; case 5: kind = K_GU; sub = 2; break; default: kind = K_RES; sub = 2; break; } }
    else { l = 2 * pair + 1;
        switch (r - 7) { case 0: kind = K_GU; sub = 0; break; case 1: kind = K_RES; sub = 0; break; case 2: kind = K_QKV; break; case 3: kind = K_QKN; break; case 4: kind = K_ATT; break;
                         case 5: kind = K_RES; sub = 1; break; case 6: kind = K_GU; sub = 2; break; default: kind = K_RES; sub = 2; break; } }
}

__global__ void __launch_bounds__(NTHR, 2) mk_fwd(Params p) {
    extern __shared__ __attribute__((aligned(16))) unsigned char lds_raw[];
    LAS unsigned char* lds = (LAS unsigned char*)lds_raw;
    cg::grid_group grid = cg::this_grid();
    unsigned char* ws = p.ws;
    float* rowss = (float*)(ws + O_ROWSS);
    bf16_t* XG = (bf16_t*)(ws + O_XG); bf16_t* MIXA = (bf16_t*)(ws + O_MIXA); bf16_t* HB = (bf16_t*)(ws + O_H);
    float* XC = (float*)(ws + O_XC);

    volatile LAS unsigned* bst = (volatile LAS unsigned*)(lds + 131072 + 1024);
    if (threadIdx.x == 0) { bst[0] = 0u; bst[1] = 0u; }
    __syncthreads();
    XcdBarrier xbar; xbar.bar = (unsigned*)(ws + O_BAR); xbar.x = 0; xbar.st = bst;
    for (int s = p.st_lo; s < p.st_hi; ++s) {
        int kind, l, sub; decode_stage(s, kind, l, sub);
        const int j = l >> 1; const bool lastl = (l == 3);
        unsigned char* wl = ws + O_W + (size_t)l * SZ_WL;
        for (int rep = 0; rep < 1 + (((MK_REPEAT) >> kind) & 1); ++rep)
        switch (kind) {
        case K_P0A: if (EN(0)) p0a(p, lds); break;
        case K_P0B: if (EN(1)) p0b(p, lds); break;
        case K_P0C: if (EN(2)) {
            p0c_rows(p);
            int start = 0;
            for (int q = 0; q < 16; ++q) {
                const int ll = q >> 2, w = q & 3; unsigned char* wq = ws + O_W + (size_t)ll * SZ_WL; const bool ev = (ll & 1) == 0;
                int site, N, coff; const bf16_t* Bt;
                if (w == 0) { site = ll * 3; N = NGU; coff = 0; Bt = (const bf16_t*)(wq + W_GU1); }
                else if (w == 1) { site = ll * 3 + 2; N = NGU; coff = 0; Bt = (const bf16_t*)(wq + W_GU2); }
                else if (w == 2) { site = ll * 3 + 1; N = ev ? 1024 : 1536; coff = 0; Bt = (const bf16_t*)(wq + W_MIX); }
                else { if (!ev) continue; site = ll * 3 + 1; N = 1024; coff = 1024; Bt = (const bf16_t*)(wq + W_MIX) + (size_t)1024 * 1024; }
                EpiSW E{(float*)(ws + O_SW) + (size_t)site * 9 * NGU, NGU, coff};
                run_gemm<EpiSW>(lds, (const bf16_t*)(ws + O_SP) + (size_t)site * 256 * 1024, Bt, 256, N, 1024, start, E);
                start += N / 256;
            }
        } break;
        case K_GU: if (EN(3)) {
            const int site = l * 3 + sub; const int M = (lastl && sub == 2) ? ML : MT;
            EpiGU E{HB, rowss + (size_t)site * MT, (const float*)(ws + O_SW) + (size_t)site * 9 * NGU};
            run_gemm<EpiGU>(lds, XG, (const bf16_t*)(wl + (sub == 0 ? W_GU1 : W_GU2)), M, NGU, 1024, 0, E);
            if (l == 0 && sub == 0) gen_dft(ws, lds);
        } break;
        case K_RES: if (EN(4)) {
            const int gsite = l * 3 + sub, nsite = gsite + 1; const bool fin = (nsite == 12);
            const int M = (lastl && sub >= 1) ? ML : MT;
            const bf16_t* A = (sub == 1 && (l & 1) == 0) ? MIXA : HB; const int K = sub == 1 ? 1024 : HP;
            const bf16_t* Bt = (const bf16_t*)(wl + (sub == 0 ? W_D1 : (sub == 2 ? W_D2 : W_MIX + 2 * SZ_WM)));
            EpiRes E{p.out, XC, (const float*)(ws + O_GT) + (size_t)gsite * 9 * 1024, fin ? nullptr : (const float*)(ws + O_GS) + (size_t)nsite * 9 * 1024, XG, rowss + (size_t)nsite * MT,
                     gsite == 0 ? p.in[I_X] : (const float*)p.out, gsite == 0 ? p.in[I_CTX] : (const float*)XC};
            const bool split = (sub != 1 && M == MT);
            run_gemm<EpiRes>(lds, A, Bt, split ? ML : M, 1024, K, 0, E);
            if (split) {
                float* slab = (float*)(ws + O_MIXA);
                for (int q = 0; q < 4; ++q) { const int k0 = (q >> 1) * 1408 + (q & 1) * 640, len = (q & 1) ? 768 : 640;
                    EpiPart EP{slab + (size_t)q * MC * 1024, 1024};
                    run_gemm<EpiPart>(lds, A + (size_t)ML * HP + k0, Bt + k0, MC, 1024, len, 64 * q, EP, HP); }
                xcd_barrier(xbar);
                ctx_fixup(ws, slab, E.gate, E.gsn, E.rowss_next, E.xic);
            }
        } break;
        case K_INEV: if (EN(5)) {
            const int site = l * 3 + 1; const float* sw = (const float*)(ws + O_SW) + (size_t)site * 9 * NGU;
            EpiUV E1{(bf16_t*)(ws + O_UV), rowss + (size_t)site * MT, sw};
            run_gemm<EpiUV>(lds, XG, (const bf16_t*)(wl + W_MIX), MT, 1024, 1024, 0, E1);
            EpiFT E2{(bf16_t*)(ws + O_FT), (bf16_t*)(ws + O_FTC), rowss + (size_t)site * MT, sw + 1024};
            run_gemm<EpiFT>(lds, (const bf16_t*)(wl + W_MIX + SZ_WM), XG, 1024, MT, 1024, (MT / 256 * 4) % 256, E2);
        } break;
        case K_MIXEV: if (EN(6)) {
            float* slabP = (float*)(ws + O_XG); float* slabR = slabP + (size_t)2048 * 4096;
            { EpiPart EP{slabP, 4096}; run_gemm<EpiPart>(lds, (const bf16_t*)(ws + O_DFT), (const bf16_t*)(ws + O_FT), 2048, 4096, 4096, 0, EP, 8192); }
            { EpiPart ER{slabR, 4096}; run_gemm<EpiPart>(lds, (const bf16_t*)(ws + O_DFT) + 4096, (const bf16_t*)(ws + O_FT) + 4096, 2048, 4096, 4096, 128, ER, 8192); }
            if (!lastl) { EpiDFT E2{MIXA, NCTX, ML};
                run_gemm<EpiDFT>(lds, (const bf16_t*)(ws + O_DFTC), (const bf16_t*)(ws + O_FTC), 256, 4096, 512, 0, E2); }
            const int nit = 4 * (MT / 128);
            for (int it = blockIdx.x; it < nit; it += opaque_G())
                sgu_item(lds, it, (const bf16_t*)(ws + O_UV), MIXA, (const bf16_t*)(ws + O_WSB) + (size_t)j * 4 * 16384, p.in[I_GV] + j * 512, p.in[I_BS] + j * 512);
            xcd_barrier(xbar);
            dft_combine(ws, slabP, slabR);
        } break;
        case K_QKV: if (EN(7)) {
            const int site = l * 3 + 1;
            EpiQKV E{(bf16_t*)(ws + O_QKRAW), (bf16_t*)(ws + O_VB), rowss + (size_t)site * MT, (const float*)(ws + O_SW) + (size_t)site * 9 * NGU};
            run_gemm<EpiQKV>(lds, XG, (const bf16_t*)(wl + W_MIX), MT, 1536, 1024, 0, E);
        } break;
        case K_QKN: if (EN(8)) qknorm_phase(p, j); break;
        case K_ATT: if (EN(9)) attn_phase(p, lds_raw, !lastl); break;
        default: if (EN(10)) final_phase(p); break;
        }
        if (s + 1 < p.st_hi) { if (s == p.st_lo) { grid.sync(); xbar = xcd_barrier_post((unsigned*)(ws + O_BAR), bst); } else xcd_barrier(xbar); }
    }
}

#ifndef MK_MULTI
#define MK_MULTI 0
#endif
extern "C" void kernel_launch(void* const* d_in, const int* in_sizes, int n_in, void* d_out, int out_size, void* d_ws, size_t ws_size, hipStream_t stream) {
    static int grid = 0;
    if (grid == 0) {
        if (n_in != 23 || out_size != ML * 1024 || ws_size < WS_END) { fprintf(stderr, "kernel_launch: unexpected shapes (n_in %d out %d ws %zu need %zu)\n", n_in, out_size, ws_size, (size_t)WS_END); grid = -1; return; }
        int dev = 0, cus = 0, per_cu = 0;
        hipGetDevice(&dev); hipDeviceGetAttribute(&cus, hipDeviceAttributeMultiprocessorCount, dev);
        if (hipFuncSetAttribute((const void*)mk_fwd, hipFuncAttributeMaxDynamicSharedMemorySize, LDS_BYTES) != hipSuccess) { fprintf(stderr, "kernel_launch: hipFuncSetAttribute failed\n"); grid = -1; return; }
        hipOccupancyMaxActiveBlocksPerMultiprocessor(&per_cu, (const void*)mk_fwd, NTHR, LDS_BYTES);
        if (per_cu < 1) { fprintf(stderr, "kernel_launch: occupancy query says %d\n", per_cu); per_cu = 1; }
        grid = cus * 1;
        fprintf(stderr, "kernel_launch: grid %d (cus %d, per_cu %d)\n", grid, cus, per_cu);
    }
    if (grid < 0) return;
    Params p{};
    for (int i = 0; i < 23; ++i) p.in[i] = (const float*)d_in[i];
    p.out = (float*)d_out; p.ws = (unsigned char*)d_ws;
#if MK_MULTI
    for (int s = 0; s < NSTAGE; ++s) { p.st_lo = s; p.st_hi = s + 1; void* args[] = {&p};
        hipError_t e = hipLaunchCooperativeKernel((const void*)mk_fwd, dim3(grid), dim3(NTHR), args, LDS_BYTES, stream);
        if (e != hipSuccess) { fprintf(stderr, "launch %d failed: %s\n", s, hipGetErrorString(e)); break; } }
#else
    p.st_lo = 0; p.st_hi = NSTAGE; void* args[] = {&p};
    hipError_t e = hipLaunchCooperativeKernel((const void*)mk_fwd, dim3(grid), dim3(NTHR), args, LDS_BYTES, stream);
    if (e != hipSuccess) fprintf(stderr, "cooperative launch failed: %s (grid %d)\n", hipGetErrorString(e), grid);
#endif
}
```

```cpp
#include <hip/hip_runtime.h>
#include <hip/hip_bf16.h>
#include <hip/hip_cooperative_groups.h>
#include <cstdio>
#include <cstdint>
#include <cmath>
namespace cg = cooperative_groups;
__device__ __forceinline__ int opaque_tid() { int t = (int)threadIdx.x; asm volatile("" : "+v"(t)); return t; }
#define LAS __attribute__((address_space(3)))
__device__ __forceinline__ int opaque_G() { int g = (int)gridDim.x; asm volatile("" : "+s"(g)); return g; }
namespace pg8 {
#define PG8_LAS __attribute__((address_space(3)))
typedef unsigned short bf16_t;
typedef short bf16x8 __attribute__((ext_vector_type(8)));
typedef float f32x4 __attribute__((ext_vector_type(4)));
typedef unsigned u32x4 __attribute__((ext_vector_type(4)));
constexpr int BM = 256, BK = 64, HALF = 128, HTB = HALF * BK * 2  , STAGE_BYTES = 8 * HTB, NXCD = 8, WGM = 4;

__host__ __device__ __forceinline__ int lds_byte(int r, int c) { const int st = (r >> 4) * 2 + (c >> 5), rr = r & 15, cc = c & 31, ob = rr * 64 + cc * 2; return st * 1024 + (ob ^ (((ob >> 9) & 1) << 5)); }
__host__ __device__ __forceinline__ void stage_rc(int b, int& R, int& C) { const int st = b / 1024, sb = b % 1024, swz = sb ^ (((sb >> 9) & 1) << 5); R = (st >> 1) * 16 + swz / 64; C = (st & 1) * 32 + (swz % 64) / 2; }
__host__ __device__ __forceinline__ int perm32(int rho) { const int n = rho >> 4, i = rho & 15; return 8 * (i >> 2) + 4 * n + (i & 3); }

struct Unit { int pm, pn; };
struct Gemm { const bf16_t* A; const bf16_t* Bt; int M, N, K, ld; };

struct StaticOrder {
    int nM, nN, nwg, G, c;
    __host__ __device__ void init(int M, int N, int G_, int c_) { nM = M / BM; nN = N / BM; nwg = nM * nN; G = G_; c = c_; }
    __host__ __device__ bool next(int i, Unit& u) const {
        const long L = (long)i * G + c; if (L >= nwg) return false;
        int wgid = (int)L; { const int q = nwg / NXCD, r = nwg % NXCD, xcd = wgid % NXCD, off = wgid / NXCD; wgid = (xcd < r ? xcd * (q + 1) : r * (q + 1) + (xcd - r) * q) + off; }
        const int nig = WGM * nN, gid = wgid / nig, fm = gid * WGM, gsz = (nM - fm) < WGM ? (nM - fm) : WGM;
        u.pm = fm + ((wgid % nig) % gsz); u.pn = (wgid % nig) / gsz; return true;
    }
    __device__ __forceinline__ void a_ready(const Unit&) const {}
    __device__ __forceinline__ void done(const Unit&) const {}
};


template <class Epi, class Sched, bool ALIGN_EPI = false, bool SP2 = false>
__device__ __forceinline__ void gemm_phase(PG8_LAS unsigned char* lds, const Gemm g, const Sched& S, const Epi& E) {
    const int tid = ::opaque_tid(), wid = __builtin_amdgcn_readfirstlane(tid >> 6), lane = tid & 63, wr = wid >> 2, wc = wid & 3, fr = lane & 15, fq = lane >> 4;
    const int K = g.K, nt = K / BK, LD = g.ld;
    unsigned voffA[2], voffB[2];
#pragma unroll
    for (int i = 0; i < 2; ++i) { int R, C; stage_rc(tid * 16 + i * 8192, R, C); const int Rb = Epi::PERM ? ((R & ~31) + perm32(R & 31)) : R;
        voffA[i] = (unsigned)(R * LD + C) * 2u; voffB[i] = (unsigned)(Rb * LD + C) * 2u; }
    const size_t kstep = (size_t)(BK * 2);
    const size_t hstep = (size_t)HALF * LD * 2;
    const size_t tstep = 2 * hstep;
    const unsigned ldsw = (unsigned)wid * 1024u;
    const int aoff = lds_byte(wr * 64 + fr, fq * 8), boff = lds_byte(wc * 32 + fr, fq * 8);
#define PG8_SA(b, h) (((b) * 2 + (h)) * HTB)
#define PG8_SB(b, h) ((4 + (b) * 2 + (h)) * HTB)
#define PG8_STAGE(bufoff, gbase, voff) do { _Pragma("unroll") for (int _i = 0; _i < 2; ++_i) \
        __builtin_amdgcn_global_load_lds((const unsigned*)((const char*)(gbase) + (voff)[_i]), (PG8_LAS unsigned*)(lds + (bufoff) + ldsw + _i * 8192), 16, 0, 0); } while (0)
#define PG8_LDA(dst, b, h) do { _Pragma("unroll") for (int m = 0; m < 4; ++m) _Pragma("unroll") for (int k = 0; k < 2; ++k) dst[m][k] = *(const PG8_LAS bf16x8*)(lds + PG8_SA(b, h) + aoff + m * 2048 + k * 1024); } while (0)
#define PG8_LDB(dst, b, h) do { _Pragma("unroll") for (int n = 0; n < 2; ++n) _Pragma("unroll") for (int k = 0; k < 2; ++k) dst[n][k] = *(const PG8_LAS bf16x8*)(lds + PG8_SB(b, h) + boff + n * 2048 + k * 1024); } while (0)
#define PG8_MMA(ai, bj, At, Bt) do { __builtin_amdgcn_s_setprio(1); _Pragma("unroll") for (int m = 0; m < 4; ++m) _Pragma("unroll") for (int n = 0; n < 2; ++n) _Pragma("unroll") for (int k = 0; k < 2; ++k) \
        acc[ai][bj][m][n] = __builtin_amdgcn_mfma_f32_16x16x32_bf16(Bt[n][k], At[m][k], acc[ai][bj][m][n], 0, 0, 0); __builtin_amdgcn_s_setprio(0); } while (0)
#define PG8_WAIT_V(n) asm volatile("s_waitcnt vmcnt(" #n ")" ::: "memory")
#define PG8_WAIT_L(n) asm volatile("s_waitcnt lgkmcnt(" #n ")" ::: "memory")
#define PG8_BAR __builtin_amdgcn_s_barrier()
#define PG8_SCHED __builtin_amdgcn_sched_barrier(0)
    Unit cur, nxt; int ui = 0;
    if (!S.next(0, cur)) return;
    f32x4 acc[2][2][4][2];
#pragma unroll
    for (int a = 0; a < 2; ++a)
#pragma unroll
        for (int b = 0; b < 2; ++b)
#pragma unroll
            for (int m = 0; m < 4; ++m)
#pragma unroll
                for (int n = 0; n < 2; ++n) acc[a][b][m][n] = (f32x4){0.f, 0.f, 0.f, 0.f};
    bf16x8 At[4][2], B0[2][2], B1[2][2];
    const char* cA = (const char*)g.A + (size_t)cur.pm * tstep; const char* cB = (const char*)g.Bt + (size_t)cur.pn * tstep;
    S.a_ready(cur);
    if constexpr (SP2) {
        PG8_STAGE(PG8_SB(0, 0), cB, voffB); PG8_STAGE(PG8_SB(0, 1), cB + hstep, voffB); PG8_STAGE(PG8_SA(0, 0), cA, voffA); PG8_STAGE(PG8_SA(0, 1), cA + hstep, voffA);
        if (wr == 1) PG8_BAR;
        PG8_WAIT_V(2); PG8_BAR;
        PG8_STAGE(PG8_SB(1, 0), cB + kstep, voffB); PG8_STAGE(PG8_SA(1, 0), cA + kstep, voffA); PG8_STAGE(PG8_SB(1, 1), cB + hstep + kstep, voffB);
        PG8_WAIT_V(6); PG8_BAR;
    } else {
        PG8_STAGE(PG8_SB(0, 0), cB, voffB); PG8_STAGE(PG8_SA(0, 0), cA, voffA); PG8_STAGE(PG8_SB(0, 1), cB + hstep, voffB); PG8_STAGE(PG8_SA(0, 1), cA + hstep, voffA);
        if (wr == 1) PG8_BAR;
        PG8_WAIT_V(4); PG8_BAR;
        PG8_STAGE(PG8_SB(1, 0), cB + kstep, voffB); PG8_STAGE(PG8_SA(1, 0), cA + kstep, voffA); PG8_STAGE(PG8_SB(1, 1), cB + hstep + kstep, voffB);
        PG8_WAIT_V(6); PG8_BAR;
    }
    for (;;) {
        const bool has_next = S.next(ui + 1, nxt);
        const char* nA = has_next ? (const char*)g.A + (size_t)nxt.pm * tstep : cA; const char* nB = has_next ? (const char*)g.Bt + (size_t)nxt.pn * tstep : cB;
        for (int t = 0; t < nt; t += 2) {
            const bool last = (t == nt - 2);
            const char* a1 = cA + (size_t)(t + 1) * kstep;
            const char* a2 = last ? nA : cA + (size_t)(t + 2) * kstep; const char* b2 = last ? nB : cB + (size_t)(t + 2) * kstep;
            const char* a3 = a2 + kstep; const char* b3 = b2 + kstep;
            if (last && has_next) S.a_ready(nxt);
            if constexpr (SP2) {
            PG8_LDB(B0, 0, 0); PG8_LDB(B1, 0, 1); PG8_SCHED; PG8_LDA(At, 0, 0); PG8_STAGE(PG8_SA(1, 1), a1 + hstep, voffA);
            PG8_WAIT_V(8); PG8_WAIT_L(0); PG8_BAR; PG8_MMA(0, 0, At, B0); PG8_MMA(0, 1, At, B1); PG8_BAR; PG8_SCHED;
            PG8_LDA(At, 0, 1); PG8_STAGE(PG8_SB(0, 0), b2, voffB); PG8_STAGE(PG8_SB(0, 1), b2 + hstep, voffB); PG8_STAGE(PG8_SA(0, 0), a2, voffA);
            PG8_WAIT_V(8); PG8_WAIT_L(0); PG8_BAR; PG8_MMA(1, 0, At, B0); PG8_MMA(1, 1, At, B1); PG8_BAR; PG8_SCHED;
            PG8_LDB(B0, 1, 0); PG8_LDB(B1, 1, 1); PG8_SCHED; PG8_LDA(At, 1, 0); PG8_STAGE(PG8_SA(0, 1), a2 + hstep, voffA);
            PG8_WAIT_V(8); PG8_WAIT_L(0); PG8_BAR; PG8_MMA(0, 0, At, B0); PG8_MMA(0, 1, At, B1); PG8_BAR; PG8_SCHED;
            PG8_LDA(At, 1, 1); PG8_STAGE(PG8_SB(1, 0), b3, voffB); PG8_STAGE(PG8_SB(1, 1), b3 + hstep, voffB); PG8_STAGE(PG8_SA(1, 0), a3, voffA);
            PG8_WAIT_V(8); PG8_WAIT_L(0); PG8_BAR; PG8_MMA(1, 0, At, B0); PG8_MMA(1, 1, At, B1); PG8_BAR; PG8_SCHED;
            } else {
            PG8_LDB(B0, 0, 0); PG8_SCHED; PG8_LDA(At, 0, 0); PG8_STAGE(PG8_SA(1, 1), a1 + hstep, voffA);
            PG8_WAIT_L(8); PG8_BAR; PG8_WAIT_L(0); PG8_MMA(0, 0, At, B0); PG8_BAR; PG8_SCHED;
            PG8_LDB(B1, 0, 1); PG8_STAGE(PG8_SB(0, 0), b2, voffB);
            PG8_BAR; PG8_WAIT_L(0); PG8_MMA(0, 1, At, B1); PG8_BAR;
            PG8_LDA(At, 0, 1); PG8_STAGE(PG8_SA(0, 0), a2, voffA);
            PG8_BAR; PG8_WAIT_L(0); PG8_MMA(1, 0, At, B0); PG8_BAR; PG8_SCHED;
            PG8_STAGE(PG8_SB(0, 1), b2 + hstep, voffB);
            PG8_WAIT_V(6); PG8_BAR; PG8_MMA(1, 1, At, B1); PG8_BAR;
            PG8_LDB(B0, 1, 0); PG8_SCHED; PG8_LDA(At, 1, 0); PG8_STAGE(PG8_SA(0, 1), a2 + hstep, voffA);
            PG8_WAIT_L(8); PG8_BAR; PG8_WAIT_L(0); PG8_MMA(0, 0, At, B0); PG8_BAR; PG8_SCHED;
            PG8_LDB(B1, 1, 1); PG8_STAGE(PG8_SB(1, 0), b3, voffB);
            PG8_BAR; PG8_WAIT_L(0); PG8_MMA(0, 1, At, B1); PG8_BAR;
            PG8_LDA(At, 1, 1); PG8_STAGE(PG8_SA(1, 0), a3, voffA);
            PG8_BAR; PG8_WAIT_L(0); PG8_MMA(1, 0, At, B0); PG8_BAR; PG8_SCHED;
            PG8_STAGE(PG8_SB(1, 1), b3 + hstep, voffB);
            PG8_WAIT_V(6); PG8_BAR; PG8_MMA(1, 1, At, B1); PG8_BAR;
            }
        }
        if constexpr (ALIGN_EPI) { if (wr == 0) PG8_BAR; }
        if constexpr (!Epi::AFTER_DRAIN) { E(acc, cur, wr, wc, fr, fq); S.done(cur); }
        if (!has_next) break;
#pragma unroll
        for (int a = 0; a < 2; ++a)
#pragma unroll
            for (int b = 0; b < 2; ++b)
#pragma unroll
                for (int m = 0; m < 4; ++m)
#pragma unroll
                    for (int n = 0; n < 2; ++n) acc[a][b][m][n] = (f32x4){0.f, 0.f, 0.f, 0.f};
        cur = nxt; cA = nA; cB = nB; ++ui;
        if constexpr (ALIGN_EPI) { if (wr == 1) PG8_BAR; }
    }
    PG8_WAIT_V(0);
    if constexpr (!ALIGN_EPI) { if (wr == 0) PG8_BAR; }
    PG8_BAR;
    if constexpr (Epi::AFTER_DRAIN) { E.fused(acc, cur, wr, wc, fr, fq, lds, wid, lane); S.done(cur); }
#undef PG8_SA
#undef PG8_SB
#undef PG8_STAGE
#undef PG8_LDA
#undef PG8_LDB
#undef PG8_MMA
#undef PG8_WAIT_V
#undef PG8_WAIT_L
#undef PG8_BAR
#undef PG8_SCHED
}
}
namespace attn {
using bf16 = __hip_bfloat16;
constexpr int   D = 128, NW = 8, QBLK = 32, KVBLK = 64;
constexpr float SCALE = 0.088388347648318440f;
constexpr float THR = 8.f;
constexpr int SDEPTH = 2;
constexpr int LDQ = 1024, LDK = 128, LDO = 1024;
constexpr size_t SHM_V = KVBLK * D * 2, SHM_K = KVBLK * D * 2, SHM_ATTN = 2 * SHM_V + 2 * SHM_K + NW * 64 * 4;
__device__ __forceinline__ unsigned f2bf_rne(float f) { unsigned u = __builtin_bit_cast(unsigned, f); return (u + 0x7fffu + ((u >> 16) & 1u)) >> 16; }
using bf16x8 = __attribute__((ext_vector_type(8))) short;
using s16x4  = __attribute__((ext_vector_type(4))) short;
using f32x16 = __attribute__((ext_vector_type(16))) float;
using f32x8  = __attribute__((ext_vector_type(8))) float;
using u32x4  = __attribute__((ext_vector_type(4))) unsigned;
#define KSWZ(row, colB) ((row) * 256 + ((colB) ^ (((row) & 7) << 4)))
#define SBAR() __builtin_amdgcn_sched_barrier(0)
__device__ __forceinline__ int crow(int r, int hi) { return (r & 3) + 8 * (r >> 2) + 4 * hi; }
__device__ __forceinline__ unsigned cvtpk(float lo, float hi) {
  unsigned r; asm volatile("v_cvt_pk_bf16_f32 %0, %1, %2" : "=v"(r) : "v"(lo), "v"(hi)); return r;
}
template <typename TIn> struct Stage;
template <> struct Stage<bf16>  { using T = bf16x8;
  __device__ static __forceinline__ T ld8(const bf16* p) { return *reinterpret_cast<const bf16x8*>(p); }
  __device__ static __forceinline__ bf16x8 tobf(T x) { return x; } };
template <> struct Stage<float> { using T = f32x8;
  __device__ static __forceinline__ T ld8(const float* p) { return *reinterpret_cast<const f32x8*>(p); }
  __device__ static __forceinline__ bf16x8 tobf(T x) {
    u32x4 w = {cvtpk(x[0], x[1]), cvtpk(x[2], x[3]), cvtpk(x[4], x[5]), cvtpk(x[6], x[7])}; return *reinterpret_cast<bf16x8*>(&w); } };

__device__ __forceinline__ void partialSM(f32x16& p0, f32x16& p1, float& m_reg, float& mn, float& alpha) {
  constexpr float C = SCALE * 1.4426950408889634f;
  float pmax = p0[0]; for (int r = 1; r < 16; ++r) pmax = fmaxf(pmax, p0[r]); for (int r = 0; r < 16; ++r) pmax = fmaxf(pmax, p1[r]);
  { auto rr = __builtin_amdgcn_permlane32_swap(__float_as_uint(pmax), __float_as_uint(pmax), false, false);
    pmax = fmaxf(__uint_as_float(rr[0]), __uint_as_float(rr[1])); }
  if (__builtin_expect(__all(pmax - m_reg <= THR / SCALE), 1)) { mn = m_reg; alpha = 1.f; }
  else { mn = fmaxf(m_reg, pmax); alpha = __builtin_amdgcn_exp2f((m_reg - mn) * C); m_reg = mn; }
  float mnC = -mn * C;
  for (int r = 0; r < 16; ++r) p0[r] = fmaf(p0[r], C, mnC); for (int r = 0; r < 16; ++r) p1[r] = fmaf(p1[r], C, mnC);
  for (int r = 0; r < 16; ++r) p0[r] = __builtin_amdgcn_exp2f(p0[r]);
}
__device__ __forceinline__ void finishSM(f32x16& p0, f32x16& p1, float alpha, float& l_reg, bf16x8& pa0, bf16x8& pa1, bf16x8& pa2, bf16x8& pa3) {
  for (int r = 0; r < 16; ++r) p1[r] = __builtin_amdgcn_exp2f(p1[r]);
  float ps = 0; for (int r = 0; r < 16; ++r) ps += p0[r]; for (int r = 0; r < 16; ++r) ps += p1[r];
  { auto rr = __builtin_amdgcn_permlane32_swap(__float_as_uint(ps), __float_as_uint(ps), false, false);
    ps = __uint_as_float(rr[0]) + __uint_as_float(rr[1]); }
  l_reg = l_reg * alpha + ps;
#define PK4(P, BASE, OUT) do { unsigned a0 = cvtpk(P[BASE + 0], P[BASE + 1]), a1 = cvtpk(P[BASE + 2], P[BASE + 3]);   \
    unsigned b0 = cvtpk(P[BASE + 4], P[BASE + 5]), b1 = cvtpk(P[BASE + 6], P[BASE + 7]);                              \
    auto r0 = __builtin_amdgcn_permlane32_swap(a0, b0, false, false); auto r1 = __builtin_amdgcn_permlane32_swap(a1, b1, false, false); \
    u32x4 w = {r0[0], r1[0], r0[1], r1[1]}; OUT = *reinterpret_cast<bf16x8*>(&w); } while (0)
  PK4(p0, 0, pa0); PK4(p0, 8, pa1); PK4(p1, 0, pa2); PK4(p1, 8, pa3);
#undef PK4
}
__device__ __forceinline__ void qkt(f32x16& p0, f32x16& p1, const bf16* Ks, const bf16x8* qr, int r32, int hi) {
  p0 = f32x16{}; p1 = f32x16{};
  for (int d0 = 0; d0 < 8; ++d0) { int cb = (d0 * 16 + hi * 8) * 2;
    bf16x8 b0 = *reinterpret_cast<const bf16x8*>((const char*)Ks + KSWZ(r32, cb));
    bf16x8 b1 = *reinterpret_cast<const bf16x8*>((const char*)Ks + KSWZ(32 + r32, cb));
    p0 = __builtin_amdgcn_mfma_f32_32x32x16_bf16(b0, qr[d0], p0, 0, 0, 0);
    p1 = __builtin_amdgcn_mfma_f32_32x32x16_bf16(b1, qr[d0], p1, 0, 0, 0); }
}
__device__ __forceinline__ int v_st(int k, int c) { const int kk = (k & ~0xC) | ((k & 4) << 1) | ((k & 8) >> 1); return ((kk >> 3) * 4 + (c >> 5)) * 512 + ((kk & 7) * 32 + (c & 31)) * 2; }
__device__ __forceinline__ int v_rd_base(int lane) { return ((lane & 3) << 3) | (((lane >> 2) & 3) << 6) | (((lane >> 4) & 1) << 5) | (((lane >> 5) & 1) << 8); }
constexpr int v_rd_off(int d0, int ks, int half) { return d0 * 512 + ks * 4096 + half * 2048; }
template <int OFF> __device__ __forceinline__ s16x4 tr_read(int vb) {
  s16x4 r; asm volatile("ds_read_b64_tr_b16 %0, %1 offset:%2" : "=&v"(r) : "v"(vb), "i"(OFF) : "memory"); return r;
}
template <int D0> __device__ __forceinline__ void pv_one(f32x16& od, int vb, bf16x8 pa0, bf16x8 pa1, bf16x8 pa2, bf16x8 pa3) {
  const s16x4 l0 = tr_read<v_rd_off(D0, 0, 0)>(vb), h0 = tr_read<v_rd_off(D0, 0, 1)>(vb), l1 = tr_read<v_rd_off(D0, 1, 0)>(vb), h1 = tr_read<v_rd_off(D0, 1, 1)>(vb);
  const s16x4 l2 = tr_read<v_rd_off(D0, 2, 0)>(vb), h2 = tr_read<v_rd_off(D0, 2, 1)>(vb), l3 = tr_read<v_rd_off(D0, 3, 0)>(vb), h3 = tr_read<v_rd_off(D0, 3, 1)>(vb);
  asm volatile("s_waitcnt lgkmcnt(0)" ::: "memory"); SBAR();
#define PK(L, H) (bf16x8){L[0], L[1], L[2], L[3], H[0], H[1], H[2], H[3]}
  od = __builtin_amdgcn_mfma_f32_32x32x16_bf16(pa0, PK(l0, h0), od, 0, 0, 0);
  od = __builtin_amdgcn_mfma_f32_32x32x16_bf16(pa1, PK(l1, h1), od, 0, 0, 0);
  od = __builtin_amdgcn_mfma_f32_32x32x16_bf16(pa2, PK(l2, h2), od, 0, 0, 0);
  od = __builtin_amdgcn_mfma_f32_32x32x16_bf16(pa3, PK(l3, h3), od, 0, 0, 0);
#undef PK
}
__device__ __forceinline__ void pv_d0(f32x16* o, int vb, bf16x8 pa0, bf16x8 pa1, bf16x8 pa2, bf16x8 pa3) {
  pv_one<0>(o[0], vb, pa0, pa1, pa2, pa3); pv_one<1>(o[1], vb, pa0, pa1, pa2, pa3); pv_one<2>(o[2], vb, pa0, pa1, pa2, pa3); pv_one<3>(o[3], vb, pa0, pa1, pa2, pa3);
}

template <typename TQ>
__device__ __forceinline__ void attn_dense_body(const TQ* __restrict__ Qb, const bf16* __restrict__ Kh, const bf16* __restrict__ Vh,
                                                unsigned short* __restrict__ Ob, int seq, char* lds) {
  using St = Stage<bf16>; using SQ = Stage<TQ>;
  const int tid = ::opaque_tid(), wid = tid >> 6, lane = tid & 63, r32 = lane & 31, hi = lane >> 5;
  bf16* V_lds = (bf16*)lds; bf16* K_lds = (bf16*)(lds + 2 * SHM_V);
  float* ws = (float*)(lds + 2 * SHM_V + 2 * SHM_K) + wid * 64; float* li_l = ws; float* al_l = ws + 32;
  float m_reg = -1e30f, l_reg = 0; f32x16 o[4] = {}; bf16x8 qr[8];
  const TQ* Qw = Qb + (long)(wid * QBLK + r32) * LDQ + hi * 8;
#pragma unroll
  for (int d0 = 0; d0 < 8; ++d0) qr[d0] = SQ::tobf(SQ::ld8(Qw + d0 * 16));
  const int sr = tid >> 4, sc = (tid & 15) * 8, vst0 = v_st(sr, sc), vst1 = v_st(32 + sr, sc);
  const int vb0 = (int)(uintptr_t)V_lds + v_rd_base(lane);
  struct { typename St::T vs0, vs1, ks0, ks1; } sr_[SDEPTH];
#define SLOAD(i, k0) do { sr_[i].vs0 = St::ld8(&Vh[(long)((k0) + sr) * LDK + sc]); sr_[i].vs1 = St::ld8(&Vh[(long)((k0) + 32 + sr) * LDK + sc]); \
    sr_[i].ks0 = St::ld8(&Kh[(long)((k0) + sr) * LDK + sc]); sr_[i].ks1 = St::ld8(&Kh[(long)((k0) + 32 + sr) * LDK + sc]); } while (0)
#define SWRITE(b, i) do { *(bf16x8*)((char*)V_lds + (b) * SHM_V + vst0) = St::tobf(sr_[i].vs0);          \
    *(bf16x8*)((char*)V_lds + (b) * SHM_V + vst1) = St::tobf(sr_[i].vs1); int kc = sc * 2;               \
    *(bf16x8*)((char*)K_lds + (b) * SHM_K + KSWZ(sr, kc)) = St::tobf(sr_[i].ks0);                       \
    *(bf16x8*)((char*)K_lds + (b) * SHM_K + KSWZ(32 + sr, kc)) = St::tobf(sr_[i].ks1); } while (0)
#define SWAIT() do { if constexpr (SDEPTH == 2) asm volatile("s_waitcnt vmcnt(4)" ::: "memory"); else asm volatile("s_waitcnt vmcnt(0)" ::: "memory"); } while (0)
#define RESC(a) do { if (__any((a) < 1.f)) { if (hi == 0) al_l[r32] = (a); asm volatile("s_waitcnt lgkmcnt(0)" ::: "memory"); \
    for (int d = 0; d < 4; ++d) for (int r = 0; r < 16; ++r) o[d][r] *= al_l[crow(r, hi)]; } } while (0)
  f32x16 pA0, pA1, pB0, pB1; float mnA, mnB, alA, alB; bf16x8 pa0, pa1, pa2, pa3; const int NT = seq / KVBLK;
  constexpr int SE = 0, SO = SDEPTH - 1;
  SLOAD(SE, 0); asm volatile("s_waitcnt vmcnt(0)" ::: "memory"); SWRITE(0, SE); __syncthreads();
  qkt(pA0, pA1, K_lds, qr, r32, hi); partialSM(pA0, pA1, m_reg, mnA, alA);
  SLOAD(SO, KVBLK); if constexpr (SDEPTH == 2) { if (2 < NT) SLOAD(SE, 2 * KVBLK); }
  SWAIT(); SWRITE(1, SO); __syncthreads();
  for (int j = 1; j + 1 < NT; j += 2) {
    SBAR(); qkt(pB0, pB1, (bf16*)((char*)K_lds + SHM_K), qr, r32, hi);
    finishSM(pA0, pA1, alA, l_reg, pa0, pa1, pa2, pa3); SBAR();
    SLOAD(SO, (j + SDEPTH) * KVBLK); SBAR();
    pv_d0(o, vb0, pa0, pa1, pa2, pa3); partialSM(pB0, pB1, m_reg, mnB, alB);
    __syncthreads(); SWAIT(); SWRITE(0, SE);
    RESC(alB); __syncthreads();
    SBAR(); qkt(pA0, pA1, K_lds, qr, r32, hi);
    finishSM(pB0, pB1, alB, l_reg, pa0, pa1, pa2, pa3); SBAR();
    if (SDEPTH == 1 || j + 3 < NT) SLOAD(SE, (j + 1 + SDEPTH) * KVBLK); SBAR();
    pv_d0(o, vb0 + (int)SHM_V, pa0, pa1, pa2, pa3); partialSM(pA0, pA1, m_reg, mnA, alA);
    __syncthreads(); SWAIT(); SWRITE(1, SO);
    RESC(alA); __syncthreads();
  }
  SBAR(); qkt(pB0, pB1, (bf16*)((char*)K_lds + SHM_K), qr, r32, hi);
  finishSM(pA0, pA1, alA, l_reg, pa0, pa1, pa2, pa3); SBAR();
  pv_d0(o, vb0, pa0, pa1, pa2, pa3); partialSM(pB0, pB1, m_reg, mnB, alB);
  __syncthreads(); RESC(alB);
  finishSM(pB0, pB1, alB, l_reg, pa0, pa1, pa2, pa3); SBAR();
  pv_d0(o, vb0 + (int)SHM_V, pa0, pa1, pa2, pa3);
  if (hi == 0) li_l[r32] = l_reg; asm volatile("s_waitcnt lgkmcnt(0)" ::: "memory");
  float rli[16];
#pragma unroll
  for (int r = 0; r < 16; ++r) rli[r] = __builtin_amdgcn_rcpf(li_l[crow(r, hi)]);
  __syncthreads();
  unsigned short* Os = (unsigned short*)lds + wid * (32 * 136);
#pragma unroll
  for (int r = 0; r < 16; ++r) { const int orow = crow(r, hi);
#pragma unroll
    for (int d0 = 0; d0 < 4; ++d0) Os[orow * 136 + d0 * 32 + r32] = (unsigned short)f2bf_rne(o[d0][r] * rli[r]); }
  asm volatile("s_waitcnt lgkmcnt(0)" ::: "memory");
  unsigned short* Ow = Ob + (long)(wid * QBLK) * LDO;
#pragma unroll
  for (int i = 0; i < 8; ++i) { const int cidx = lane + 64 * i, row = cidx >> 4, seg = cidx & 15;
    const u32x4 v = *reinterpret_cast<const u32x4*>(Os + row * 136 + seg * 8);
    *reinterpret_cast<u32x4*>(Ow + (long)row * LDO + seg * 8) = v; }
#undef SLOAD
#undef SWRITE
#undef SWAIT
#undef RESC
}

#undef KSWZ
#undef SBAR
}
#define XB_TMO      128
#define XB_XCNT(j)  (256  + 64 * (j))
#define XB_XSUB(j)  (1280 + 64 * (j))
#define XB_XGEN(j)  (2304 + 64 * (j))
#define XB_TOP      3328
#define XB_TOPGEN   3392
#define XCD_BAR_WORDS 3456
#define XB_SPIN_CAP (1u << 18)

__device__ __forceinline__ unsigned xb_ld(unsigned* p)              { return __hip_atomic_load(p, __ATOMIC_RELAXED, __HIP_MEMORY_SCOPE_AGENT); }
__device__ __forceinline__ unsigned xb_add(unsigned* p, unsigned v) { return __hip_atomic_fetch_add(p, v, __ATOMIC_RELAXED, __HIP_MEMORY_SCOPE_AGENT); }
__device__ __forceinline__ unsigned xb_xcc_id() { return (unsigned)__builtin_amdgcn_s_getreg((3 << 11) | 20) & 0xFu; }
#define XB_SPIN(cond, bar) do { unsigned _sp = 0; while (cond) { __builtin_amdgcn_s_sleep(1); \
    if ((++_sp & 255u) == 0u) { if (xb_ld(&(bar)[XB_TMO])) break; if (_sp > XB_SPIN_CAP) { atomicAdd(&(bar)[XB_TMO], 1u); break; } } } } while (0)

struct XcdBarrier {
    unsigned* bar; unsigned x;
    volatile LAS unsigned* st;
};

__device__ __forceinline__ XcdBarrier xcd_barrier_post(unsigned* bar, volatile LAS unsigned* st) {
    XcdBarrier b; b.bar = bar; b.x = xb_xcc_id(); b.st = st;
    if (threadIdx.x == 0) (void)xb_add(&bar[XB_XCNT(b.x)], 1u);
    return b;
}
__device__ __forceinline__ void xcd_barrier_complete(unsigned* bar, unsigned x, unsigned& nloc, unsigned& nx) {
    const unsigned G = gridDim.x * gridDim.y * gridDim.z;
    unsigned sum, cnt, mine, sp = 0u;
    for (;;) {
        sum = 0u; cnt = 0u; mine = 0u;
#pragma unroll
        for (unsigned j = 0; j < 16; ++j) { const unsigned c = xb_ld(&bar[XB_XCNT(j)]); sum += c; cnt += (c > 0u) ? 1u : 0u; mine = (j == x) ? c : mine; }
        if (sum == G) break;
        __builtin_amdgcn_s_sleep(1);
        if ((++sp & 255u) == 0u) { if (xb_ld(&bar[XB_TMO])) break; if (sp > XB_SPIN_CAP) { atomicAdd(&bar[XB_TMO], 1u); break; } }
    }
    nloc = mine > 0u ? mine : 1u; nx = cnt > 0u ? cnt : 1u;
}

__device__ __forceinline__ void xcd_barrier(const XcdBarrier& b) {
    asm volatile("s_waitcnt vmcnt(0)" ::: "memory");
    __syncthreads();
    if (threadIdx.x == 0) {
        unsigned* bar = b.bar;
        __builtin_amdgcn_s_waitcnt(0);
        unsigned nloc = b.st[0], nx = b.st[1];
        if (nloc == 0u) { xcd_barrier_complete(bar, b.x, nloc, nx); b.st[0] = nloc; b.st[1] = nx; }
        const unsigned old = xb_add(&bar[XB_XSUB(b.x)], 1u);
        const unsigned gen = old / nloc;
        if (old + 1u == (gen + 1u) * nloc) {
            __builtin_amdgcn_fence(__ATOMIC_RELEASE, "agent");
            asm volatile("s_waitcnt vmcnt(0)" ::: "memory");
            const unsigned og = xb_add(&bar[XB_TOP], 1u);
            const unsigned tg = og / nx;
            if (og + 1u == (tg + 1u) * nx) xb_add(&bar[XB_TOPGEN], 1u);
            else XB_SPIN(xb_ld(&bar[XB_TOPGEN]) == tg, bar);
            __builtin_amdgcn_fence(__ATOMIC_ACQUIRE, "agent");
            xb_add(&bar[XB_XGEN(b.x)], 1u);
            asm volatile("s_waitcnt vmcnt(0)" ::: "memory");
        } else {
            XB_SPIN(xb_ld(&bar[XB_XGEN(b.x)]) == gen, bar);
            __builtin_amdgcn_fence(__ATOMIC_ACQUIRE, "agent");
            asm volatile("s_waitcnt vmcnt(0)" ::: "memory");
        }
    }
    __syncthreads();
}

using pg8::bf16_t; using pg8::f32x4; using pg8::u32x4; using pg8::bf16x8; using pg8::Unit;
typedef unsigned u32x2 __attribute__((ext_vector_type(2)));
typedef float f32x16 __attribute__((ext_vector_type(16)));

constexpr int DM = 1024, NB = 8, SEQ = 4096, NCTX = 256, ML = NB * SEQ, MC = NB * NCTX, MT = ML + MC;
constexpr int DFF = 2752, HP = 2816, NGU = 2 * HP;
constexpr int KEYS = SEQ + NCTX;
constexpr float EPS = 1e-6f;
constexpr int NTHR = 512, NWAVE = 8;
constexpr int LDS_BYTES = 147456;

constexpr size_t AL(size_t x) { return (x + 255) & ~(size_t)255; }
constexpr size_t O_ROWSS = 0;
constexpr size_t O_BAR   = AL(O_ROWSS + (size_t)13 * MT * 4);
constexpr size_t O_MODS  = AL(O_BAR + (size_t)XCD_BAR_WORDS * 4);
constexpr size_t O_GS    = AL(O_MODS + (size_t)4 * 9 * 9216 * 4);
constexpr size_t O_GT    = AL(O_GS + (size_t)12 * 9 * 1024 * 4);
constexpr size_t O_SW    = AL(O_GT + (size_t)12 * 9 * 1024 * 4);
constexpr size_t O_SP    = AL(O_SW + (size_t)12 * 9 * NGU * 4);
constexpr size_t O_WSB   = AL(O_SP + (size_t)12 * 256 * 1024 * 2);
constexpr size_t O_XC    = AL(O_WSB + (size_t)2 * 4 * 128 * 128 * 2);
constexpr size_t O_XG    = AL(O_XC + (size_t)MC * 1024 * 4);
constexpr size_t O_MIXA  = AL(O_XG + (size_t)MT * 1024 * 2);
constexpr size_t O_H     = AL(O_MIXA + (size_t)MT * 1024 * 2);
constexpr size_t SZ_H    = (size_t)MT * HP * 2;
constexpr size_t O_UV    = O_H;
constexpr size_t O_FT    = AL(O_UV + (size_t)MT * 1024 * 2);
constexpr size_t O_FTC   = AL(O_FT + (size_t)4096 * 8192 * 2);
constexpr size_t O_QKRAW = O_H;
constexpr size_t O_WF    = O_H;
static_assert(O_FTC + (size_t)4096 * 512 * 2 <= O_H + SZ_H, "H overlay");
static_assert((size_t)MT * 1280 * 4 <= SZ_H, "H overlay qk");
constexpr size_t O_DFT   = AL(O_H + SZ_H);
constexpr size_t O_KB    = AL(O_DFT + (size_t)2048 * 8192 * 2);
constexpr size_t O_VB    = AL(O_KB + (size_t)NB * 2 * KEYS * 128 * 2);
constexpr size_t O_DFTC  = AL(O_VB + (size_t)NB * 2 * KEYS * 128 * 2);
constexpr size_t O_W     = AL(O_DFTC + (size_t)256 * 512 * 2);
constexpr size_t SZ_WGU = (size_t)NGU * 1024 * 2, SZ_WD = (size_t)1024 * HP * 2, SZ_WM = (size_t)1024 * 1024 * 2;
constexpr size_t W_GU1 = 0, W_D1 = SZ_WGU, W_GU2 = W_D1 + SZ_WD, W_D2 = W_GU2 + SZ_WGU, W_MIX = W_D2 + SZ_WD;
constexpr size_t SZ_WL = W_MIX + 3 * SZ_WM;
constexpr size_t WS_END = O_W + 4 * SZ_WL;

struct Params { const float* in[23]; float* out; unsigned char* ws; int st_lo, st_hi; };

enum { I_X = 0, I_C, I_CTX, I_CCTX, I_WMOD, I_BMOD, I_GFFN1, I_WGU1, I_WD1, I_GMIX, I_GFFN2, I_WGU2, I_WD2, I_GFINAL, I_WIN, I_GV, I_WS, I_BS, I_WOUT, I_WQKV, I_GQ, I_GK, I_WO };

__device__ __forceinline__ unsigned f2bf(float f) { unsigned u = __builtin_bit_cast(unsigned, f); return (u + 0x7fffu + ((u >> 16) & 1u)) >> 16; }
__device__ __forceinline__ unsigned pk2(float lo, float hi) { unsigned r; asm volatile("v_cvt_pk_bf16_f32 %0, %1, %2" : "=v"(r) : "v"(lo), "v"(hi)); return r; }
__device__ __forceinline__ float bf2f(unsigned short h) { return __builtin_bit_cast(float, (unsigned)h << 16); }
__device__ __forceinline__ float silu_f(float g) { return g * __builtin_amdgcn_rcpf(1.0f + __builtin_amdgcn_exp2f(-1.4426950408889634f * g)); }
__device__ __forceinline__ float gelu_tanh_f(float v) {
    const float z2 = v * (1.5957691216057308f + 0.07135481627159493f * v * v);
    return v * __builtin_amdgcn_rcpf(1.0f + __builtin_amdgcn_exp2f(-1.4426950408889634f * z2));
}
__device__ __forceinline__ int mb_of_panel(int pm) { return pm < 128 ? (pm >> 4) : 8; }
__device__ __forceinline__ float rstd_of(float ss) { return __builtin_amdgcn_rsqf(ss * (1.0f / 1024.0f) + EPS); }

typedef float f32x2v __attribute__((ext_vector_type(2)));
struct EpiGU {
    static constexpr bool PERM = true, AFTER_DRAIN = false;
    bf16_t* H; const float* rowss; const float* sw;
    __device__ __forceinline__ void operator()(const f32x4 (&acc)[2][2][4][2], const Unit& u, int wr, int wc, int fr_, int fq_) const {
        const int tl_ = opaque_tid(); const int fr = tl_ & 15, fq = (tl_ >> 4) & 3; (void)fr_; (void)fq_;
        const int mb = mb_of_panel(u.pm), row0 = u.pm * 256 + wr * 64 + fr, hc0 = u.pn * 128 + wc * 32 + 8 * fq;
        const float* swg = sw + (size_t)mb * NGU + u.pn * 256 + wc * 32 + 8 * fq;
        f32x4 bg[2], bu[2];
#pragma unroll
        for (int n = 0; n < 2; ++n) { bg[n] = *(const f32x4*)(swg + 4 * n); bu[n] = *(const f32x4*)(swg + 128 + 4 * n); }
        float rsv[2][4];
#pragma unroll
        for (int ai = 0; ai < 2; ++ai)
#pragma unroll
            for (int m = 0; m < 4; ++m) rsv[ai][m] = rstd_of(rowss[row0 + ai * 128 + m * 16]);
#pragma unroll
        for (int ai = 0; ai < 2; ++ai)
#pragma unroll
            for (int m = 0; m < 4; ++m) {
                const int r = row0 + ai * 128 + m * 16; const float rs = rsv[ai][m];
                f32x2v g[4], up[4], e[4];
#pragma unroll
                for (int n = 0; n < 2; ++n) { const f32x4 gv = acc[ai][0][m][n] * rs + bg[n], uv = acc[ai][1][m][n] * rs + bu[n];
                    g[2 * n] = (f32x2v){gv[0], gv[1]}; g[2 * n + 1] = (f32x2v){gv[2], gv[3]}; up[2 * n] = (f32x2v){uv[0], uv[1]}; up[2 * n + 1] = (f32x2v){uv[2], uv[3]}; }
#pragma unroll
                for (int q = 0; q < 4; ++q) { const f32x2v t = g[q] * -1.4426950408889634f; e[q].x = __builtin_amdgcn_exp2f(t.x); e[q].y = __builtin_amdgcn_exp2f(t.y); }
#pragma unroll
                for (int q = 0; q < 4; ++q) { const f32x2v d = e[q] + 1.0f; e[q].x = __builtin_amdgcn_rcpf(d.x); e[q].y = __builtin_amdgcn_rcpf(d.y); }
#pragma unroll
                for (int q = 0; q < 4; ++q) g[q] = (g[q] * e[q]) * up[q];
                u32x4 w; w.x = pk2(g[0].x, g[0].y); w.y = pk2(g[1].x, g[1].y); w.z = pk2(g[2].x, g[2].y); w.w = pk2(g[3].x, g[3].y);
                *(u32x4*)(H + (size_t)r * HP + hc0) = w;
            }
    }
};

struct EpiRes {
    static constexpr bool PERM = true, AFTER_DRAIN = false;
    float* xl; float* xc; const float* gate; const float* gsn; bf16_t* xg; float* rowss_next; const float* xil; const float* xic;
    __device__ __forceinline__ void operator()(const f32x4 (&acc)[2][2][4][2], const Unit& u, int wr, int wc, int fr_, int fq_) const {
        const int tl_ = opaque_tid(); const int fr = tl_ & 15, fq = (tl_ >> 4) & 3; (void)fr_; (void)fq_;
        const int mb = mb_of_panel(u.pm);
        float* xb = u.pm < 128 ? xl + (size_t)u.pm * 256 * 1024 : xc + (size_t)(u.pm - 128) * 256 * 1024;
        const float* xib = u.pm < 128 ? xil + (size_t)u.pm * 256 * 1024 : xic + (size_t)(u.pm - 128) * 256 * 1024;
        const int lr0 = wr * 64 + fr, col0 = u.pn * 256 + wc * 32 + 8 * fq;
        float* xbase = xb + (size_t)lr0 * 1024 + col0; const float* xibase = xib + (size_t)lr0 * 1024 + col0;
        bf16_t* gbase = xg + ((size_t)u.pm * 256 + lr0) * 1024 + col0;
        float ss[4];
        f32x4 xa[4][2], xbf[4][2];
#define RES_LOAD(buf, bj, ai) do { _Pragma("unroll") for (int m = 0; m < 4; ++m) { const float* px = xibase + (size_t)((ai) * 128 + m * 16) * 1024 + (bj) * 128; buf[m][0] = *(const f32x4*)px; buf[m][1] = *(const f32x4*)(px + 4); } asm volatile("" ::: "memory"); } while (0)
#define RES_PROC(buf, bj, ai) do { const f32x4 gv0 = *(const f32x4*)(gate + mb * 1024 + col0 + (bj) * 128), gv1 = *(const f32x4*)(gate + mb * 1024 + col0 + (bj) * 128 + 4); \
        f32x4 gs0 = (f32x4){0.f, 0.f, 0.f, 0.f}, gs1 = gs0; if (gsn) { gs0 = *(const f32x4*)(gsn + mb * 1024 + col0 + (bj) * 128); gs1 = *(const f32x4*)(gsn + mb * 1024 + col0 + (bj) * 128 + 4); } \
        _Pragma("unroll") for (int m = 0; m < 4; ++m) { float* px = xbase + (size_t)((ai) * 128 + m * 16) * 1024 + (bj) * 128; \
            const f32x4 xn0 = buf[m][0] + gv0 * acc[ai][bj][m][0], xn1 = buf[m][1] + gv1 * acc[ai][bj][m][1]; \
            *(f32x4*)px = xn0; *(f32x4*)(px + 4) = xn1; \
            const float sq = ((xn0[0] * xn0[0] + xn0[1] * xn0[1]) + (xn0[2] * xn0[2] + xn0[3] * xn0[3])) + ((xn1[0] * xn1[0] + xn1[1] * xn1[1]) + (xn1[2] * xn1[2] + xn1[3] * xn1[3])); \
            ss[m] = (bj) ? ss[m] + sq : sq; \
            if (gsn) { const f32x4 xs0 = xn0 * gs0, xs1 = xn1 * gs1; u32x4 w; w.x = pk2(xs0[0], xs0[1]); w.y = pk2(xs0[2], xs0[3]); w.z = pk2(xs1[0], xs1[1]); w.w = pk2(xs1[2], xs1[3]); \
                *(u32x4*)(gbase + (size_t)((ai) * 128 + m * 16) * 1024 + (bj) * 128) = w; } } asm volatile("" ::: "memory"); } while (0)
#define RES_ATOM(ai) do { _Pragma("unroll") for (int m = 0; m < 4; ++m) { float sv = ss[m]; sv += __shfl_xor(sv, 16); sv += __shfl_xor(sv, 32); \
            if (fq == 0) unsafeAtomicAdd(rowss_next + (size_t)u.pm * 256 + lr0 + (ai) * 128 + m * 16, sv); } } while (0)
        RES_LOAD(xa, 0, 0);
        RES_LOAD(xbf, 1, 0); RES_PROC(xa, 0, 0);
        RES_LOAD(xa, 0, 1); RES_PROC(xbf, 1, 0); RES_ATOM(0);
        RES_LOAD(xbf, 1, 1); RES_PROC(xa, 0, 1);
        RES_PROC(xbf, 1, 1); RES_ATOM(1);
#undef RES_LOAD
#undef RES_PROC
#undef RES_ATOM
    }
};

struct EpiUV {
    static constexpr bool PERM = true, AFTER_DRAIN = false;
    bf16_t* O; const float* rowss; const float* sw;
    __device__ __forceinline__ void operator()(const f32x4 (&acc)[2][2][4][2], const Unit& u, int wr, int wc, int fr_, int fq_) const {
        const int tl_ = opaque_tid(); const int fr = tl_ & 15, fq = (tl_ >> 4) & 3; (void)fr_; (void)fq_;
        const int mb = mb_of_panel(u.pm), row0 = u.pm * 256 + wr * 64 + fr, col0 = u.pn * 256 + wc * 32 + 8 * fq;
        f32x4 bv[2][2];
#pragma unroll
        for (int bj = 0; bj < 2; ++bj)
#pragma unroll
            for (int n = 0; n < 2; ++n) bv[bj][n] = *(const f32x4*)(sw + (size_t)mb * NGU + col0 + bj * 128 + 4 * n);
#pragma unroll
        for (int ai = 0; ai < 2; ++ai)
#pragma unroll
            for (int m = 0; m < 4; ++m) {
                const int r = row0 + ai * 128 + m * 16; const float rs = rstd_of(rowss[r]);
#pragma unroll
                for (int bj = 0; bj < 2; ++bj) {
                    const f32x4 v0 = acc[ai][bj][m][0] * rs + bv[bj][0], v1 = acc[ai][bj][m][1] * rs + bv[bj][1];
                    f32x2v g[4] = {(f32x2v){v0[0], v0[1]}, (f32x2v){v0[2], v0[3]}, (f32x2v){v1[0], v1[1]}, (f32x2v){v1[2], v1[3]}}, e[4];
#pragma unroll
                    for (int q = 0; q < 4; ++q) { const f32x2v t = (g[q] * (g[q] * g[q] * 0.07135481627159493f + 1.5957691216057308f)) * -1.4426950408889634f; e[q].x = __builtin_amdgcn_exp2f(t.x); e[q].y = __builtin_amdgcn_exp2f(t.y); }
#pragma unroll
                    for (int q = 0; q < 4; ++q) { const f32x2v d = e[q] + 1.0f; e[q].x = __builtin_amdgcn_rcpf(d.x); e[q].y = __builtin_amdgcn_rcpf(d.y); }
#pragma unroll
                    for (int q = 0; q < 4; ++q) g[q] = g[q] * e[q];
                    u32x4 w; w.x = pk2(g[0].x, g[0].y); w.y = pk2(g[1].x, g[1].y); w.z = pk2(g[2].x, g[2].y); w.w = pk2(g[3].x, g[3].y);
                    *(u32x4*)(O + (size_t)r * 1024 + col0 + bj * 128) = w;
                }
            }
    }
};

struct EpiFT {
    static constexpr bool PERM = true, AFTER_DRAIN = false;
    bf16_t* FT; bf16_t* FTC; const float* rowss; const float* sw;
    __device__ __forceinline__ void operator()(const f32x4 (&acc)[2][2][4][2], const Unit& u, int wr, int wc, int fr_, int fq_) const {
        const int tl_ = opaque_tid(); const int fr = tl_ & 15, fq = (tl_ >> 4) & 3; (void)fr_; (void)fq_;
        const int mb = mb_of_panel(u.pn), tok0 = u.pn * 256 + wc * 32 + 8 * fq;
        f32x4 rs[2][2];
#pragma unroll
        for (int bj = 0; bj < 2; ++bj)
#pragma unroll
            for (int n = 0; n < 2; ++n) { const f32x4 s = *(const f32x4*)(rowss + tok0 + bj * 128 + 4 * n);
                rs[bj][n] = (f32x4){rstd_of(s[0]), rstd_of(s[1]), rstd_of(s[2]), rstd_of(s[3])}; }
#pragma unroll
        for (int ai = 0; ai < 2; ++ai)
#pragma unroll
            for (int m = 0; m < 4; ++m) {
                const int ch = u.pm * 256 + ai * 128 + wr * 64 + m * 16 + fr, part = ch >> 9, c = ch & 511;
                const float swv = sw[(size_t)mb * NGU + ch];
#pragma unroll
                for (int bj = 0; bj < 2; ++bj) {
                    const f32x4 v0 = acc[ai][bj][m][0] * rs[bj][0] + swv, v1 = acc[ai][bj][m][1] * rs[bj][1] + swv;
                    u32x4 w; w.x = pk2(v0[0], v0[1]); w.y = pk2(v0[2], v0[3]); w.z = pk2(v1[0], v1[1]); w.w = pk2(v1[2], v1[3]);
                    bf16_t* dst;
                    if (u.pn < 128) { const int b = u.pn >> 4, npos = (u.pn & 15) * 256 + bj * 128 + wc * 32 + 8 * fq; dst = FT + ((size_t)(b * 512 + c) * 8192 + part * 4096 + npos); }
                    else { const int b = u.pn - 128, npos = bj * 128 + wc * 32 + 8 * fq; dst = FTC + ((size_t)(b * 512 + c) * 512 + part * 256 + npos); }
                    *(u32x4*)dst = w;
                }
            }
    }
};

struct EpiDFT {
    static constexpr bool PERM = true, AFTER_DRAIN = false;
    bf16_t* O; int rows_per_b, row_base;
    __device__ __forceinline__ void operator()(const f32x4 (&acc)[2][2][4][2], const Unit& u, int wr, int wc, int fr_, int fq_) const {
        const int tl_ = opaque_tid(); const int fr = tl_ & 15, fq = (tl_ >> 4) & 3; (void)fr_; (void)fq_;
        const int b = u.pn >> 1;
        bf16_t* base = O + (size_t)(row_base + b * rows_per_b + u.pm * 256 + wr * 64 + fr) * 1024 + (u.pn & 1) * 256 + wc * 32 + 8 * fq;
#pragma unroll
        for (int ai = 0; ai < 2; ++ai)
#pragma unroll
            for (int m = 0; m < 4; ++m) {
                bf16_t* rowp = base + (size_t)(ai * 128 + m * 16) * 1024;
#pragma unroll
                for (int bj = 0; bj < 2; ++bj) {
                    const f32x4 v0 = acc[ai][bj][m][0], v1 = acc[ai][bj][m][1];
                    u32x4 w; w.x = pk2(v0[0], v0[1]); w.y = pk2(v0[2], v0[3]); w.z = pk2(v1[0], v1[1]); w.w = pk2(v1[2], v1[3]);
                    *(u32x4*)(rowp + bj * 128) = w;
                }
                if (m & 1) asm volatile("" ::: "memory");
            }
    }
};

struct EpiQKV {
    static constexpr bool PERM = false, AFTER_DRAIN = false;
    bf16_t* qk; bf16_t* vb; const float* rowss; const float* sw;
    __device__ __forceinline__ void operator()(const f32x4 (&acc)[2][2][4][2], const Unit& u, int wr, int wc, int fr_, int fq_) const {
        const int tl_ = opaque_tid(); const int fr = tl_ & 15, fq = (tl_ >> 4) & 3; (void)fr_; (void)fq_;
        const int mb = mb_of_panel(u.pm), lr0 = wr * 64 + fr, col0 = u.pn * 256 + wc * 32 + 4 * fq;
        f32x4 bv[2][2];
#pragma unroll
        for (int bj = 0; bj < 2; ++bj)
#pragma unroll
            for (int n = 0; n < 2; ++n) bv[bj][n] = *(const f32x4*)(sw + (size_t)mb * NGU + col0 + bj * 128 + n * 16);
#pragma unroll
        for (int ai = 0; ai < 2; ++ai)
#pragma unroll
            for (int m = 0; m < 4; ++m) {
                const int lr = lr0 + ai * 128 + m * 16, r = u.pm * 256 + lr; const float rs = rstd_of(rowss[r]);
#pragma unroll
                for (int bj = 0; bj < 2; ++bj)
#pragma unroll
                    for (int n = 0; n < 2; ++n) {
                        const f32x4 v = acc[ai][bj][m][n] * rs + bv[bj][n];
                        if (u.pn < 5) { u32x2 w; w.x = pk2(v[0], v[1]); w.y = pk2(v[2], v[3]); *(u32x2*)(qk + (size_t)r * 1280 + col0 + bj * 128 + n * 16) = w; }
                        else { const int d = wc * 32 + 16 * n + 4 * fq; int b, key;
                            if (u.pm < 128) { b = u.pm >> 4; key = (u.pm & 15) * 256 + lr; } else { b = u.pm - 128; key = SEQ + lr; }
                            u32x2 w; w.x = pk2(v[0], v[1]); w.y = pk2(v[2], v[3]);
                            *(u32x2*)(vb + ((size_t)(b * 2 + bj) * KEYS + key) * 128 + d) = w; }
                    }
            }
    }
};

struct EpiPart {
    static constexpr bool PERM = true, AFTER_DRAIN = false;
    float* slab; int ld;
    __device__ __forceinline__ void operator()(const f32x4 (&acc)[2][2][4][2], const Unit& u, int wr, int wc, int fr_, int fq_) const {
        const int tl_ = opaque_tid(); const int fr = tl_ & 15, fq = (tl_ >> 4) & 3; (void)fr_; (void)fq_;
        float* base = slab + (size_t)(u.pm * 256 + wr * 64 + fr) * ld + u.pn * 256 + wc * 32 + 8 * fq;
#pragma unroll
        for (int ai = 0; ai < 2; ++ai)
#pragma unroll
            for (int m = 0; m < 4; ++m) { float* rowp = base + (size_t)(ai * 128 + m * 16) * ld;
#pragma unroll
                for (int bj = 0; bj < 2; ++bj) { *(f32x4*)(rowp + bj * 128) = acc[ai][bj][m][0]; *(f32x4*)(rowp + bj * 128 + 4) = acc[ai][bj][m][1]; }
                if (m & 1) asm volatile("" ::: "memory"); }
    }
};

struct EpiSW {
    static constexpr bool PERM = false, AFTER_DRAIN = false;
    float* out; int ld, coff;
    __device__ __forceinline__ void operator()(const f32x4 (&acc)[2][2][4][2], const Unit& u, int wr, int wc, int fr_, int fq_) const {
        const int tl_ = opaque_tid(); const int fr = tl_ & 15, fq = (tl_ >> 4) & 3; (void)fr_; (void)fq_;
        if (u.pm == 0 && wr == 0 && fr < 9) {
#pragma unroll
            for (int bj = 0; bj < 2; ++bj)
#pragma unroll
                for (int n = 0; n < 2; ++n) *(f32x4*)(out + (size_t)fr * ld + coff + u.pn * 256 + bj * 128 + wc * 32 + 16 * n + 4 * fq) = acc[0][bj][0][n];
        }
    }
};

template <class Epi>
__device__ __forceinline__ void run_gemm(LAS unsigned char* lds, const bf16_t* A, const bf16_t* Bt, int M, int N, int K, int rot, const Epi& E, int ld = 0) {
    pg8::Gemm g{A, Bt, M, N, K, ld ? ld : K}; pg8::StaticOrder S; const int G = opaque_G();
    int c = (int)blockIdx.x - rot; if (c < 0) c += G; if (c < 0) c += G;
    S.init(M, N, G, c);
    pg8::gemm_phase<Epi, pg8::StaticOrder, true, true>(lds, g, S, E);
}

__device__ __forceinline__ void transpose_item(const float* W, int ldw, int k0, int n0, bf16_t* dst, int ldd, LAS float* scr, int lane) {
    {
        f32x4 wv[8]; const int c4 = 4 * (lane & 7), kr = lane >> 3;
#pragma unroll
        for (int i = 0; i < 8; ++i) wv[i] = *(const f32x4*)(W + (size_t)(k0 + 8 * i + kr) * ldw + n0 + c4);
#pragma unroll
        for (int i = 0; i < 8; ++i) { LAS float* d = scr + (8 * i + kr) * 33 + c4; d[0] = wv[i][0]; d[1] = wv[i][1]; d[2] = wv[i][2]; d[3] = wv[i][3]; }
    }
    asm volatile("s_waitcnt lgkmcnt(0)" ::: "memory");
    const int c = lane & 7;
#pragma unroll
    for (int j = 0; j < 4; ++j) { const int n = (lane >> 3) + 8 * j; const LAS float* s = scr + (8 * c) * 33 + n;
        u32x4 o; o.x = pk2(s[0 * 33], s[1 * 33]); o.y = pk2(s[2 * 33], s[3 * 33]); o.z = pk2(s[4 * 33], s[5 * 33]); o.w = pk2(s[6 * 33], s[7 * 33]);
        *(u32x4*)(dst + (size_t)n * ldd + k0 + 8 * c) = o; }
    asm volatile("s_waitcnt lgkmcnt(0)" ::: "memory");
}
__device__ __forceinline__ int gu_dst_row(int n0) { const int up = n0 >= DFF, j = up ? n0 - DFF : n0; return (j >> 7) * 256 + up * 128 + (j & 127); }

constexpr int IT_GU = 16 * 172, IT_D = 43 * 32, IT_MIX = 1280, IT_L = 2 * IT_GU + 2 * IT_D + IT_MIX;

__device__ __forceinline__ void p0a(const Params& p, LAS unsigned char* lds) {
    const int tid = opaque_tid(), lane = tid & 63, wid = __builtin_amdgcn_readfirstlane(tid >> 6), G = opaque_G();
    unsigned char* ws = p.ws;
    if (blockIdx.x == 0) { unsigned* bw = (unsigned*)(ws + O_BAR); for (int i = tid; i < XCD_BAR_WORDS; i += NTHR) bw[i] = 0u; }
    {
        LAS float* scT = (LAS float*)lds;
        LAS float* part = (LAS float*)(lds + 49152);
        for (int idx = tid; idx < 9 * 1024; idx += NTHR) { const int mb = idx >> 10, k = idx & 1023; const float v = mb < 8 ? p.in[I_C][mb * 1024 + k] : p.in[I_CCTX][k]; scT[k * 12 + mb] = silu_f(v); }
        __syncthreads();
        float* mods = (float*)(ws + O_MODS);
        for (int it = blockIdx.x; it < 4 * 144; it += G) {
            const int l = it / 144, cb = it % 144, kbase = wid * 128;
            float a[9];
#pragma unroll
            for (int i = 0; i < 9; ++i) a[i] = 0.f;
            const float* wp = p.in[I_WMOD] + ((size_t)l * 1024 + kbase) * 9216 + cb * 64 + lane;
#pragma unroll 16
            for (int kk = 0; kk < 128; ++kk) {
                const float wv = wp[(size_t)kk * 9216]; const LAS float* s = scT + (kbase + kk) * 12;
                const f32x4 s0 = *(const LAS f32x4*)s, s1 = *(const LAS f32x4*)(s + 4); const float s8 = s[8];
                a[0] += s0[0] * wv; a[1] += s0[1] * wv; a[2] += s0[2] * wv; a[3] += s0[3] * wv;
                a[4] += s1[0] * wv; a[5] += s1[1] * wv; a[6] += s1[2] * wv; a[7] += s1[3] * wv; a[8] += s8 * wv;
            }
#pragma unroll
            for (int i = 0; i < 9; ++i) part[(wid * 9 + i) * 64 + lane] = a[i];
            __syncthreads();
            for (int idx = tid; idx < 576; idx += NTHR) { const int mb = idx >> 6, cl = idx & 63; float s = p.in[I_BMOD][l * 9216 + cb * 64 + cl];
#pragma unroll
                for (int w = 0; w < 8; ++w) s += part[(w * 9 + mb) * 64 + cl];
                mods[((size_t)l * 9 + mb) * 9216 + cb * 64 + cl] = s; }
            __syncthreads();
        }
    }
    __syncthreads();
    {
        LAS float* scr = (LAS float*)(lds + wid * 8448);
        const int gw = blockIdx.x * NWAVE + wid, NGW = G * NWAVE;
        for (int it = gw; it < 4 * IT_L; it += NGW) {
            const int l = it / IT_L, j = l >> 1; int r = it % IT_L;
            unsigned char* wl = ws + O_W + (size_t)l * SZ_WL;
            if (r < IT_GU) { const int kb = r / 172, nb = r % 172; transpose_item(p.in[I_WGU1] + (size_t)l * 1024 * 5504, 5504, kb * 64, nb * 32, (bf16_t*)(wl + W_GU1) + (size_t)gu_dst_row(nb * 32) * 1024, 1024, scr, lane); continue; } r -= IT_GU;
            if (r < IT_D) { const int kb = r / 32, nb = r % 32; transpose_item(p.in[I_WD1] + (size_t)l * DFF * 1024, 1024, kb * 64, nb * 32, (bf16_t*)(wl + W_D1) + (size_t)(nb * 32) * HP, HP, scr, lane); continue; } r -= IT_D;
            if (r < IT_GU) { const int kb = r / 172, nb = r % 172; transpose_item(p.in[I_WGU2] + (size_t)l * 1024 * 5504, 5504, kb * 64, nb * 32, (bf16_t*)(wl + W_GU2) + (size_t)gu_dst_row(nb * 32) * 1024, 1024, scr, lane); continue; } r -= IT_GU;
            if (r < IT_D) { const int kb = r / 32, nb = r % 32; transpose_item(p.in[I_WD2] + (size_t)l * DFF * 1024, 1024, kb * 64, nb * 32, (bf16_t*)(wl + W_D2) + (size_t)(nb * 32) * HP, HP, scr, lane); continue; } r -= IT_D;
            bf16_t* wm = (bf16_t*)(wl + W_MIX);
            if ((l & 1) == 0) {
                if (r < 512) { const int kb = r / 32, nb = r % 32; transpose_item(p.in[I_WIN] + (size_t)j * 1024 * 1536 + 512, 1536, kb * 64, nb * 32, wm + (size_t)(nb * 32) * 1024, 1024, scr, lane); }
                else if (r < 1024) { r -= 512; const int kb = r / 32, nb = r % 32; transpose_item(p.in[I_WOUT] + (size_t)j * 1024 * 1024, 1024, kb * 64, nb * 32, wm + (size_t)2 * 1024 * 1024 + (size_t)(nb * 32) * 1024, 1024, scr, lane); }
            } else {
                if (r < 768) { const int kb = r / 48, nb = r % 48; transpose_item(p.in[I_WQKV] + (size_t)j * 1024 * 1536, 1536, kb * 64, nb * 32, wm + (size_t)(nb * 32) * 1024, 1024, scr, lane); }
                else { r -= 768; const int kb = r / 32, nb = r % 32; transpose_item(p.in[I_WO] + (size_t)j * 1024 * 1024, 1024, kb * 64, nb * 32, wm + (size_t)2 * 1024 * 1024 + (size_t)(nb * 32) * 1024, 1024, scr, lane); }
            }
        }
    }
    __syncthreads();
    {
        LAS float* tab = (LAS float*)lds;
        for (int i = tid; i < 128; i += NTHR) tab[i] = cospif((float)i * (1.0f / 64.0f)) * 0.08838834764831845f;
        __syncthreads();
        float* WF = (float*)(ws + O_WF);
        const int gt = blockIdx.x * NTHR + tid, NT = G * NTHR;
        for (int idx = gt; idx < 2 * 1024 * 1024; idx += NT) {
            const int j = idx >> 20, k = (idx >> 10) & 1023, n = idx & 1023, part = n >> 9, g = (n >> 7) & 3, m = n & 127;
            const float* wr_ = p.in[I_WIN] + ((size_t)j * 1024 + k) * 1536 + g * 128; float s = 0.f; const int sh = part ? 96 : 0;
#pragma unroll 8
            for (int c = 0; c < 128; ++c) s += wr_[c] * tab[(c * m + sh) & 127];
            WF[idx] = s;
        }
    }
    {
        const int gt = blockIdx.x * NTHR + tid, NT = G * NTHR;
        unsigned zv = 0u; asm volatile("" : "+v"(zv)); const u32x4 zero4 = (u32x4){zv, zv, zv, zv};
        float* rowss = (float*)(ws + O_ROWSS);
        for (int i = gt; i < 13 * MT; i += NT) rowss[i] = __builtin_bit_cast(float, zv);
        for (int i = gt; i < 4 * 2 * 128 * 128; i += NT) {
            const int ch = i & 127, rr = (i >> 7) & 127, which = (i >> 14) & 1, l = i >> 15;
            bf16_t* base = (bf16_t*)(ws + O_W + (size_t)l * SZ_WL + (which ? W_GU2 : W_GU1));
            const int row = 21 * 256 + (rr >> 6) * 128 + 64 + (rr & 63);
            *(u32x4*)(base + (size_t)row * 1024 + ch * 8) = zero4;
        }
        for (int i = gt; i < 4 * 2 * 1024 * 8; i += NT) {
            const int ch = i & 7, rr = (i >> 3) & 1023, which = (i >> 13) & 1, l = i >> 14;
            bf16_t* base = (bf16_t*)(ws + O_W + (size_t)l * SZ_WL + (which ? W_D2 : W_D1));
            *(u32x4*)(base + (size_t)rr * HP + DFF + ch * 8) = zero4;
        }
        bf16_t* wsb = (bf16_t*)(ws + O_WSB);
        for (int i = gt; i < 2 * 4 * 128 * 128; i += NT) wsb[i] = (bf16_t)f2bf(p.in[I_WS][i]);
    }
}

__device__ __forceinline__ void p0b(const Params& p, LAS unsigned char* lds) {
    const int tid = opaque_tid(), lane = tid & 63, wid = __builtin_amdgcn_readfirstlane(tid >> 6), G = opaque_G();
    unsigned char* ws = p.ws;
    {
        LAS float* scr = (LAS float*)(lds + wid * 8448);
        const int gw = blockIdx.x * NWAVE + wid, NGW = G * NWAVE;
        for (int it = gw; it < 1024; it += NGW) { const int j = it >> 9, r = it & 511, kb = r / 32, nb = r % 32;
            bf16_t* winf = (bf16_t*)(ws + O_W + (size_t)(2 * j) * SZ_WL + W_MIX) + (size_t)1024 * 1024;
            transpose_item((const float*)(ws + O_WF) + (size_t)j * 1024 * 1024, 1024, kb * 64, nb * 32, winf + (size_t)(nb * 32) * 1024, 1024, scr, lane); }
    }
    const int gt = blockIdx.x * NTHR + tid, NT = G * NTHR;
    const float* mods = (const float*)(ws + O_MODS);
    float* GS = (float*)(ws + O_GS); float* GT = (float*)(ws + O_GT); bf16_t* SP = (bf16_t*)(ws + O_SP);
    for (int idx = gt; idx < 12 * 9 * 1024; idx += NT) {
        const int k = idx & 1023, mb = (idx >> 10) % 9, s = idx / 9216, l = s / 3, i = s % 3;
        const float* mrow = mods + ((size_t)l * 9 + mb) * 9216 + (3 * i) * 1024 + k;
        const float shift = mrow[0], scale = mrow[1024], gate = mrow[2048];
        const float g = (i == 0 ? p.in[I_GFFN1] : (i == 1 ? p.in[I_GMIX] : p.in[I_GFFN2]))[l * 1024 + k];
        GS[idx] = g * (1.0f + scale); GT[idx] = (i == 1 ? 1.0f : 0.5f) * gate;
        SP[((size_t)s * 256 + mb) * 1024 + k] = (bf16_t)f2bf(shift);
    }
    bf16_t* DFTC = (bf16_t*)(ws + O_DFTC);
    for (int idx = gt; idx < 256 * 512; idx += NT) { const int k = idx >> 9, np = idx & 511, part = np >> 8, n = np & 255, j = (k * n) & 255;
        float sn, cs; sincospif((float)j * (1.0f / 128.0f), &sn, &cs); DFTC[idx] = (bf16_t)f2bf((part ? -sn : cs) * 0.0625f); }
}

__device__ __forceinline__ void p0c_rows(const Params& p) {
    const int tid = opaque_tid(), lane = tid & 63, wid = tid >> 6, G = opaque_G();
    unsigned char* ws = p.ws; const float* GS = (const float*)(ws + O_GS); float* rowss = (float*)(ws + O_ROWSS); bf16_t* XG = (bf16_t*)(ws + O_XG);
    for (int r = blockIdx.x * NWAVE + wid; r < MT; r += G * NWAVE) {
        const float* src = r < ML ? p.in[I_X] + (size_t)r * 1024 : p.in[I_CTX] + (size_t)(r - ML) * 1024;
        const int mb = r < ML ? (r >> 12) : 8; float s = 0.f;
#pragma unroll
        for (int j = 0; j < 2; ++j) { const int c = 512 * j + 8 * lane; const f32x4 v0 = *(const f32x4*)(src + c), v1 = *(const f32x4*)(src + c + 4), g0 = *(const f32x4*)(GS + mb * 1024 + c), g1 = *(const f32x4*)(GS + mb * 1024 + c + 4);
            s += ((v0[0] * v0[0] + v0[1] * v0[1]) + (v0[2] * v0[2] + v0[3] * v0[3])) + ((v1[0] * v1[0] + v1[1] * v1[1]) + (v1[2] * v1[2] + v1[3] * v1[3]));
            const f32x4 x0 = v0 * g0, x1 = v1 * g1; u32x4 w; w.x = pk2(x0[0], x0[1]); w.y = pk2(x0[2], x0[3]); w.z = pk2(x1[0], x1[1]); w.w = pk2(x1[2], x1[3]); *(u32x4*)(XG + (size_t)r * 1024 + c) = w; }
#pragma unroll
        for (int o = 1; o < 64; o <<= 1) s += __shfl_xor(s, o);
        if (lane == 0) rowss[r] = s;
    }
}

__device__ __forceinline__ void ctx_fixup(unsigned char* ws, const float* slab, const float* gate, const float* gsn, float* rowss_next, const float* xin) {
    const int tid = opaque_tid(), lane = tid & 63, wid = tid >> 6, G = opaque_G();
    float* XC = (float*)(ws + O_XC); bf16_t* XG = (bf16_t*)(ws + O_XG);
    for (int r = blockIdx.x * NWAVE + wid; r < MC; r += G * NWAVE) {
        float s = 0.f;
#pragma unroll
        for (int j = 0; j < 4; ++j) { const int c = 256 * j + 4 * lane; const size_t o = (size_t)r * 1024 + c;
            const f32x4 p0 = *(const f32x4*)(slab + o), p1 = *(const f32x4*)(slab + (size_t)MC * 1024 + o), p2 = *(const f32x4*)(slab + (size_t)2 * MC * 1024 + o), p3 = *(const f32x4*)(slab + (size_t)3 * MC * 1024 + o);
            const f32x4 gv = *(const f32x4*)(gate + 8 * 1024 + c); const f32x4 xn = *(const f32x4*)(xin + o) + gv * ((p0 + p1) + (p2 + p3));
            *(f32x4*)(XC + o) = xn; s += (xn[0] * xn[0] + xn[1] * xn[1]) + (xn[2] * xn[2] + xn[3] * xn[3]);
            if (gsn) { const f32x4 xs = xn * *(const f32x4*)(gsn + 8 * 1024 + c); u32x2 w; w.x = pk2(xs[0], xs[1]); w.y = pk2(xs[2], xs[3]); *(u32x2*)(XG + (size_t)(ML + r) * 1024 + c) = w; } }
#pragma unroll
        for (int o = 1; o < 64; o <<= 1) s += __shfl_xor(s, o);
        if (lane == 0) rowss_next[ML + r] = s;
    }
}

__device__ __forceinline__ void gen_dft(unsigned char* ws, LAS unsigned char* lds) {
    const int tid = opaque_tid(), G = opaque_G();
    LAS float* tab = (LAS float*)lds;
    __syncthreads();
    for (int i = tid; i < 4096; i += NTHR) tab[i] = cospif((float)i * (1.0f / 2048.0f)) * (1.0f / 64.0f);
    __syncthreads();
    bf16_t* DFT = (bf16_t*)(ws + O_DFT);
    for (int k = blockIdx.x; k < 2048; k += G)
        for (int c8 = tid; c8 < 1024; c8 += NTHR) { const int n0 = c8 * 8, part = n0 >> 12, n = n0 & 4095, sh = part ? 1024 : 0;
            float v[8];
#pragma unroll
            for (int e = 0; e < 8; ++e) v[e] = tab[(k * (n + e) + sh) & 4095];
            u32x4 w; w.x = pk2(v[0], v[1]); w.y = pk2(v[2], v[3]); w.z = pk2(v[4], v[5]); w.w = pk2(v[6], v[7]);
            *(u32x4*)(DFT + (size_t)k * 8192 + n0) = w; }
    __syncthreads();
}

__device__ __forceinline__ void dft_combine(unsigned char* ws, const float* P, const float* Rm) {
    const int tid = opaque_tid(), lane = tid & 63, wid = tid >> 6, G = opaque_G();
    bf16_t* Y = (bf16_t*)(ws + O_MIXA); const bf16_t* FT = (const bf16_t*)(ws + O_FT);
    const int gt = blockIdx.x * NTHR + tid, NT = G * NTHR;
    for (int idx = gt; idx < 2048 * 512; idx += NT) {
        const int k = idx >> 9, j = (idx & 511) * 8, b = j >> 9, c = j & 511; const size_t o = (size_t)k * 4096 + j;
        const f32x4 p0 = *(const f32x4*)(P + o), p1 = *(const f32x4*)(P + o + 4), r0 = *(const f32x4*)(Rm + o), r1 = *(const f32x4*)(Rm + o + 4);
        { const f32x4 a0 = p0 + r0, a1 = p1 + r1; u32x4 w; w.x = pk2(a0[0], a0[1]); w.y = pk2(a0[2], a0[3]); w.z = pk2(a1[0], a1[1]); w.w = pk2(a1[2], a1[3]);
          *(u32x4*)(Y + (size_t)(b * SEQ + k) * 1024 + c) = w; }
        if (k) { const f32x4 a0 = p0 - r0, a1 = p1 - r1; u32x4 w; w.x = pk2(a0[0], a0[1]); w.y = pk2(a0[2], a0[3]); w.z = pk2(a1[0], a1[1]); w.w = pk2(a1[2], a1[3]);
          *(u32x4*)(Y + (size_t)(b * SEQ + 4096 - k) * 1024 + c) = w; }
    }
    for (int j = blockIdx.x * NWAVE + wid; j < 4096; j += G * NWAVE) {
        const bf16_t* src = FT + (size_t)j * 8192 + lane * 64; float sacc = 0.f;
#pragma unroll
        for (int q = 0; q < 8; ++q) { const u32x4 w = *(const u32x4*)(src + 8 * q);
#pragma unroll
            for (int e = 0; e < 4; ++e) sacc += __builtin_bit_cast(float, w[e] << 16) - __builtin_bit_cast(float, w[e] & 0xffff0000u); }
#pragma unroll
        for (int o = 1; o < 64; o <<= 1) sacc += __shfl_xor(sacc, o);
        if (lane == 0) Y[(size_t)((j >> 9) * SEQ + 2048) * 1024 + (j & 511)] = (bf16_t)f2bf(sacc * (1.0f / 64.0f));
    }
}

__device__ __forceinline__ int crow16(int r, int hi) { return (r & 3) + 8 * (r >> 2) + 4 * hi; }

__device__ __forceinline__ void sgu_item(LAS unsigned char* lds, int it, const bf16_t* UV, bf16_t* MixA, const bf16_t* wsb, const float* gv, const float* bs) {
    const int tid = opaque_tid(), lane = tid & 63, wid = tid >> 6, chunk = it >> 2, h = it & 3, tok0 = chunk * 128;
    LAS bf16_t* vT = (LAS bf16_t*)lds;
    LAS bf16_t* wL = (LAS bf16_t*)(lds + 128 * 136 * 2);
    {
        const int q = tid >> 2, d0 = (tid & 3) * 32; const bf16_t* src = UV + (size_t)(tok0 + q) * 1024 + 512 + h * 128 + d0;
        float v[32]; float ss = 0.f;
#pragma unroll
        for (int i = 0; i < 4; ++i) { const u32x4 w = *(const u32x4*)(src + 8 * i);
#pragma unroll
            for (int e = 0; e < 4; ++e) { v[8 * i + 2 * e] = __builtin_bit_cast(float, w[e] << 16); v[8 * i + 2 * e + 1] = __builtin_bit_cast(float, w[e] & 0xffff0000u); } }
#pragma unroll
        for (int e = 0; e < 32; ++e) ss += v[e] * v[e];
        ss += __shfl_xor(ss, 1); ss += __shfl_xor(ss, 2);
        const float rs = 1.0f / sqrtf(ss * (1.0f / 128.0f) + EPS);
#pragma unroll
        for (int e = 0; e < 32; ++e) vT[(d0 + e) * 136 + q] = (bf16_t)f2bf(v[e] * rs * gv[h * 128 + d0 + e]);
#pragma unroll
        for (int i = 0; i < 4; ++i) { const int idx = tid + NTHR * i, pp = idx >> 4, seg = idx & 15;
            *(LAS u32x4*)(wL + pp * 136 + seg * 8) = *(const u32x4*)(wsb + (size_t)h * 16384 + pp * 128 + seg * 8); }
    }
    __syncthreads();
    const int tp = wid >> 1, tdb = (wid & 1) * 2, r32 = lane & 31, hi = lane >> 5;
    f32x16 a0 = {}, a1 = {};
#pragma unroll
    for (int kk = 0; kk < 8; ++kk) {
        const bf16x8 a = *(const LAS bf16x8*)(wL + (tp * 32 + r32) * 136 + kk * 16 + hi * 8);
        const bf16x8 b0 = *(const LAS bf16x8*)(vT + (tdb * 32 + r32) * 136 + kk * 16 + hi * 8);
        const bf16x8 b1 = *(const LAS bf16x8*)(vT + ((tdb + 1) * 32 + r32) * 136 + kk * 16 + hi * 8);
        a0 = __builtin_amdgcn_mfma_f32_32x32x16_bf16(a, b0, a0, 0, 0, 0);
        a1 = __builtin_amdgcn_mfma_f32_32x32x16_bf16(a, b1, a1, 0, 0, 0);
    }
    __syncthreads();
    LAS float* Mt = (LAS float*)lds;
#pragma unroll
    for (int r = 0; r < 16; ++r) {
        const int pp = tp * 32 + crow16(r, hi); const float bsv = bs[h * 128 + pp];
        Mt[pp * 132 + tdb * 32 + r32] = a0[r] + bsv; Mt[pp * 132 + (tdb + 1) * 32 + r32] = a1[r] + bsv;
    }
    __syncthreads();
    {
        const int pp = tid >> 2, c0 = (tid & 3) * 32; const size_t rowoff = (size_t)(tok0 + pp) * 1024 + h * 128 + c0;
        u32x4 uw[4];
#pragma unroll
        for (int i = 0; i < 4; ++i) uw[i] = *(const u32x4*)(UV + rowoff + 8 * i);
#pragma unroll
        for (int i = 0; i < 4; ++i) {
            const f32x4 m0 = *(const LAS f32x4*)(Mt + pp * 132 + c0 + 8 * i), m1 = *(const LAS f32x4*)(Mt + pp * 132 + c0 + 8 * i + 4);
            u32x4 w;
            w.x = pk2(__builtin_bit_cast(float, uw[i].x << 16) * m0[0], __builtin_bit_cast(float, uw[i].x & 0xffff0000u) * m0[1]);
            w.y = pk2(__builtin_bit_cast(float, uw[i].y << 16) * m0[2], __builtin_bit_cast(float, uw[i].y & 0xffff0000u) * m0[3]);
            w.z = pk2(__builtin_bit_cast(float, uw[i].z << 16) * m1[0], __builtin_bit_cast(float, uw[i].z & 0xffff0000u) * m1[1]);
            w.w = pk2(__builtin_bit_cast(float, uw[i].w << 16) * m1[2], __builtin_bit_cast(float, uw[i].w & 0xffff0000u) * m1[3]);
            *(u32x4*)(MixA + rowoff + 512 + 8 * i) = w;
        }
    }
    __syncthreads();
}

__device__ __forceinline__ void qknorm_phase(const Params& p, int j) {
    const int tid = opaque_tid(), lane = tid & 63, wid = tid >> 6, G = opaque_G(), sub = lane >> 4, jl = lane & 15;
    unsigned char* ws = p.ws; const bf16_t* qk = (const bf16_t*)(ws + O_QKRAW); bf16_t* Qb = (bf16_t*)(ws + O_MIXA); bf16_t* Kb = (bf16_t*)(ws + O_KB);
    const float* gq = p.in[I_GQ] + j * 128 + 8 * jl; const float* gk = p.in[I_GK] + j * 128 + 8 * jl;
    const f32x4 gq0 = *(const f32x4*)gq, gq1 = *(const f32x4*)(gq + 4), gk0 = *(const f32x4*)gk, gk1 = *(const f32x4*)(gk + 4);
    const int half = jl >> 3, x2 = (jl >> 2) & 1;
    float inv[8];
#pragma unroll
    for (int e = 0; e < 8; ++e) inv[e] = __builtin_amdgcn_exp2f(-(float)(8 * (jl & 3) + e) * 0.41524101186092029f);
    const int nitems = MT * 10;
    for (int st = blockIdx.x * NWAVE + wid; st < nitems / 32; st += G * NWAVE) {
        u32x4 raw[8];
#pragma unroll
        for (int u = 0; u < 8; ++u) { const int it = st * 32 + u * 4 + sub; raw[u] = *(const u32x4*)(qk + (size_t)it * 128 + 8 * jl); }
#pragma unroll
        for (int u = 0; u < 8; ++u) {
            const int it = st * 32 + u * 4 + sub, t = it / 10, hh = it % 10;
            float y[8]; float ss = 0.f;
#pragma unroll
            for (int w = 0; w < 4; ++w) { y[2 * w] = __builtin_bit_cast(float, raw[u][w] << 16); y[2 * w + 1] = __builtin_bit_cast(float, raw[u][w] & 0xffff0000u); }
#pragma unroll
            for (int e = 0; e < 8; ++e) ss += y[e] * y[e];
            ss += __shfl_xor(ss, 1); ss += __shfl_xor(ss, 2); ss += __shfl_xor(ss, 4); ss += __shfl_xor(ss, 8);
            const float rs = 1.0f / sqrtf(ss * (1.0f / 128.0f) + EPS);
            const f32x4 g0 = hh < 8 ? gq0 : gk0, g1 = hh < 8 ? gq1 : gk1;
#pragma unroll
            for (int e = 0; e < 4; ++e) { y[e] *= rs * g0[e]; y[4 + e] *= rs * g1[e]; }
            if (t < ML) { const int n = t & 4095; const float pos = half ? (float)(n & 63) : (float)(n >> 6);
#pragma unroll
                for (int e = 0; e < 8; ++e) { const float ang = pos * inv[e], sn = __sinf(ang), cs = __cosf(ang), pv = __shfl_xor(y[e], 4);
                    y[e] = x2 ? y[e] * cs + pv * sn : y[e] * cs - pv * sn; } }
            u32x4 w; w.x = pk2(y[0], y[1]); w.y = pk2(y[2], y[3]); w.z = pk2(y[4], y[5]); w.w = pk2(y[6], y[7]);
            bf16_t* dst;
            if (hh < 8) dst = Qb + (size_t)t * 1024 + hh * 128;
            else { int b, key; if (t < ML) { b = t >> 12; key = t & 4095; } else { b = (t - ML) >> 8; key = SEQ + ((t - ML) & 255); }
                dst = Kb + ((size_t)(b * 2 + (hh - 8)) * KEYS + key) * 128; }
            *(u32x4*)(dst + 8 * jl) = w;
        }
    }
}

__device__ __forceinline__ void attn_phase(const Params& p, unsigned char* lds_generic, bool with_ctx) {
    unsigned char* ws = p.ws; unsigned short* Q = (unsigned short*)(ws + O_MIXA);
    const attn::bf16* Kb = (const attn::bf16*)(ws + O_KB); const attn::bf16* Vb = (const attn::bf16*)(ws + O_VB);
    const int nunits = with_ctx ? 1024 + 64 : 1024;
    for (int i = blockIdx.x; i < nunits; i += opaque_G()) {
        size_t qoff, koff; int seq;
        if (i < 1024) { const int qb = i & 15, h = (i >> 4) & 7, b = i >> 7; qoff = ((size_t)(b * SEQ + qb * 256)) * 1024 + h * 128; koff = (size_t)(b * 2 + (h >> 2)) * KEYS * 128; seq = KEYS; }
        else { const int jj = i - 1024, h = jj & 7, b = jj >> 3; qoff = ((size_t)(ML + b * NCTX)) * 1024 + h * 128; koff = ((size_t)(b * 2 + (h >> 2)) * KEYS + SEQ) * 128; seq = NCTX; }
        attn::attn_dense_body<attn::bf16>((const attn::bf16*)(Q + qoff), Kb + koff, Vb + koff, (unsigned short*)(ws + O_H) + qoff, seq, (char*)lds_generic);
        __syncthreads();
    }
}

__device__ __forceinline__ void final_phase(const Params& p) {
    const int tid = opaque_tid(), lane = tid & 63, wid = tid >> 6, G = opaque_G();
    const float* rowss = (const float*)(p.ws + O_ROWSS) + (size_t)12 * MT; const float* g = p.in[I_GFINAL];
    for (int r = blockIdx.x * NWAVE + wid; r < ML; r += G * NWAVE) {
        const float rs = rstd_of(rowss[r]); float* row = p.out + (size_t)r * 1024;
#pragma unroll
        for (int j = 0; j < 4; ++j) { const int c = 256 * j + 4 * lane; const f32x4 v = *(const f32x4*)(row + c), gg = *(const f32x4*)(g + c); *(f32x4*)(row + c) = v * rs * gg; }
    }
}

#ifndef MK_REPEAT
#define MK_REPEAT 0
#endif
#ifndef MK_MASK
#define MK_MASK 0xFFFF
#endif
#define EN(k) (((MK_MASK) >> (k)) & 1)
enum { K_P0A = 0, K_P0B, K_P0C, K_GU, K_RES, K_INEV, K_MIXEV, K_QKV, K_QKN, K_ATT, K_FINAL };
constexpr int NSTAGE = 3 + 30 + 1;

__device__ __forceinline__ void decode_stage(int s, int& kind, int& l, int& sub) {
    l = 0; sub = 0;
    if (s < 3) { kind = s; return; }
    if (s == NSTAGE - 1) { kind = K_FINAL; return; }
    const int t = s - 3, pair = t / 15, r = t % 15;
    if (r < 7) { l = 2 * pair;
        switch (r) { case 0: kind = K_GU; sub = 0; break; case 1: kind = K_RES; sub = 0; break; case 2: kind = K_INEV; break; case 3: kind = K_MIXEV; break;
                     case 4: kind = K_RES; sub = 1; break; case 5: kind = K_GU; sub = 2; break; default: kind = K_RES; sub = 2; break; } }
    else { l = 2 * pair + 1;
        switch (r - 7) { case 0: kind = K_GU; sub = 0; break; case 1: kind = K_RES; sub = 0; break; case 2: kind = K_QKV; break; case 3: kind = K_QKN; break; case 4: kind = K_ATT; break;
                         case 5: kind = K_RES; sub = 1; break; case 6: kind = K_GU; sub = 2; break; default: kind = K_RES; sub = 2; break; } }
}

__global__ void __launch_bounds__(NTHR, 2) mk_fwd(Params p) {
    extern __shared__ __attribute__((aligned(16))) unsigned char lds_raw[];
    LAS unsigned char* lds = (LAS unsigned char*)lds_raw;
    cg::grid_group grid = cg::this_grid();
    unsigned char* ws = p.ws;
    float* rowss = (float*)(ws + O_ROWSS);
    bf16_t* XG = (bf16_t*)(ws + O_XG); bf16_t* MIXA = (bf16_t*)(ws + O_MIXA); bf16_t* HB = (bf16_t*)(ws + O_H);
    float* XC = (float*)(ws + O_XC);

    volatile LAS unsigned* bst = (volatile LAS unsigned*)(lds + 131072 + 1024);
    if (threadIdx.x == 0) { bst[0] = 0u; bst[1] = 0u; }
    __syncthreads();
    XcdBarrier xbar; xbar.bar = (unsigned*)(ws + O_BAR); xbar.x = 0; xbar.st = bst;
    for (int s = p.st_lo; s < p.st_hi; ++s) {
        int kind, l, sub; decode_stage(s, kind, l, sub);
        const int j = l >> 1; const bool lastl = (l == 3);
        unsigned char* wl = ws + O_W + (size_t)l * SZ_WL;
        for (int rep = 0; rep < 1 + (((MK_REPEAT) >> kind) & 1); ++rep)
        switch (kind) {
        case K_P0A: if (EN(0)) p0a(p, lds); break;
        case K_P0B: if (EN(1)) p0b(p, lds); break;
        case K_P0C: if (EN(2)) {
            p0c_rows(p);
            int start = 0;
            for (int q = 0; q < 16; ++q) {
                const int ll = q >> 2, w = q & 3; unsigned char* wq = ws + O_W + (size_t)ll * SZ_WL; const bool ev = (ll & 1) == 0;
                int site, N, coff; const bf16_t* Bt;
                if (w == 0) { site = ll * 3; N = NGU; coff = 0; Bt = (const bf16_t*)(wq + W_GU1); }
                else if (w == 1) { site = ll * 3 + 2; N = NGU; coff = 0; Bt = (const bf16_t*)(wq + W_GU2); }
                else if (w == 2) { site = ll * 3 + 1; N = ev ? 1024 : 1536; coff = 0; Bt = (const bf16_t*)(wq + W_MIX); }
                else { if (!ev) continue; site = ll * 3 + 1; N = 1024; coff = 1024; Bt = (const bf16_t*)(wq + W_MIX) + (size_t)1024 * 1024; }
                EpiSW E{(float*)(ws + O_SW) + (size_t)site * 9 * NGU, NGU, coff};
                run_gemm<EpiSW>(lds, (const bf16_t*)(ws + O_SP) + (size_t)site * 256 * 1024, Bt, 256, N, 1024, start, E);
                start += N / 256;
            }
        } break;
        case K_GU: if (EN(3)) {
            const int site = l * 3 + sub; const int M = (lastl && sub == 2) ? ML : MT;
            EpiGU E{HB, rowss + (size_t)site * MT, (const float*)(ws + O_SW) + (size_t)site * 9 * NGU};
            run_gemm<EpiGU>(lds, XG, (const bf16_t*)(wl + (sub == 0 ? W_GU1 : W_GU2)), M, NGU, 1024, 0, E);
            if (l == 0 && sub == 0) gen_dft(ws, lds);
        } break;
        case K_RES: if (EN(4)) {
            const int gsite = l * 3 + sub, nsite = gsite + 1; const bool fin = (nsite == 12);
            const int M = (lastl && sub >= 1) ? ML : MT;
            const bf16_t* A = (sub == 1 && (l & 1) == 0) ? MIXA : HB; const int K = sub == 1 ? 1024 : HP;
            const bf16_t* Bt = (const bf16_t*)(wl + (sub == 0 ? W_D1 : (sub == 2 ? W_D2 : W_MIX + 2 * SZ_WM)));
            EpiRes E{p.out, XC, (const float*)(ws + O_GT) + (size_t)gsite * 9 * 1024, fin ? nullptr : (const float*)(ws + O_GS) + (size_t)nsite * 9 * 1024, XG, rowss + (size_t)nsite * MT,
                     gsite == 0 ? p.in[I_X] : (const float*)p.out, gsite == 0 ? p.in[I_CTX] : (const float*)XC};
            const bool split = (sub != 1 && M == MT);
            run_gemm<EpiRes>(lds, A, Bt, split ? ML : M, 1024, K, 0, E);
            if (split) {
                float* slab = (float*)(ws + O_MIXA);
                for (int q = 0; q < 4; ++q) { const int k0 = (q >> 1) * 1408 + (q & 1) * 640, len = (q & 1) ? 768 : 640;
                    EpiPart EP{slab + (size_t)q * MC * 1024, 1024};
                    run_gemm<EpiPart>(lds, A + (size_t)ML * HP + k0, Bt + k0, MC, 1024, len, 64 * q, EP, HP); }
                xcd_barrier(xbar);
                ctx_fixup(ws, slab, E.gate, E.gsn, E.rowss_next, E.xic);
            }
        } break;
        case K_INEV: if (EN(5)) {
            const int site = l * 3 + 1; const float* sw = (const float*)(ws + O_SW) + (size_t)site * 9 * NGU;
            EpiUV E1{(bf16_t*)(ws + O_UV), rowss + (size_t)site * MT, sw};
            run_gemm<EpiUV>(lds, XG, (const bf16_t*)(wl + W_MIX), MT, 1024, 1024, 0, E1);
            EpiFT E2{(bf16_t*)(ws + O_FT), (bf16_t*)(ws + O_FTC), rowss + (size_t)site * MT, sw + 1024};
            run_gemm<EpiFT>(lds, (const bf16_t*)(wl + W_MIX + SZ_WM), XG, 1024, MT, 1024, (MT / 256 * 4) % 256, E2);
        } break;
        case K_MIXEV: if (EN(6)) {
            float* slabP = (float*)(ws + O_XG); float* slabR = slabP + (size_t)2048 * 4096;
            { EpiPart EP{slabP, 4096}; run_gemm<EpiPart>(lds, (const bf16_t*)(ws + O_DFT), (const bf16_t*)(ws + O_FT), 2048, 4096, 4096, 0, EP, 8192); }
            { EpiPart ER{slabR, 4096}; run_gemm<EpiPart>(lds, (const bf16_t*)(ws + O_DFT) + 4096, (const bf16_t*)(ws + O_FT) + 4096, 2048, 4096, 4096, 128, ER, 8192); }
            if (!lastl) { EpiDFT E2{MIXA, NCTX, ML};
                run_gemm<EpiDFT>(lds, (const bf16_t*)(ws + O_DFTC), (const bf16_t*)(ws + O_FTC), 256, 4096, 512, 0, E2); }
            const int nit = 4 * (MT / 128);
            for (int it = blockIdx.x; it < nit; it += opaque_G())
                sgu_item(lds, it, (const bf16_t*)(ws + O_UV), MIXA, (const bf16_t*)(ws + O_WSB) + (size_t)j * 4 * 16384, p.in[I_GV] + j * 512, p.in[I_BS] + j * 512);
            xcd_barrier(xbar);
            dft_combine(ws, slabP, slabR);
        } break;
        case K_QKV: if (EN(7)) {
            const int site = l * 3 + 1;
            EpiQKV E{(bf16_t*)(ws + O_QKRAW), (bf16_t*)(ws + O_VB), rowss + (size_t)site * MT, (const float*)(ws + O_SW) + (size_t)site * 9 * NGU};
            run_gemm<EpiQKV>(lds, XG, (const bf16_t*)(wl + W_MIX), MT, 1536, 1024, 0, E);
        } break;
        case K_QKN: if (EN(8)) qknorm_phase(p, j); break;
        case K_ATT: if (EN(9)) attn_phase(p, lds_raw, !lastl); break;
        default: if (EN(10)) final_phase(p); break;
        }
        if (s + 1 < p.st_hi) { if (s == p.st_lo) { grid.sync(); xbar = xcd_barrier_post((unsigned*)(ws + O_BAR), bst); } else xcd_barrier(xbar); }
    }
}

#ifndef MK_MULTI
#define MK_MULTI 0
#endif
extern "C" void kernel_launch(void* const* d_in, const int* in_sizes, int n_in, void* d_out, int out_size, void* d_ws, size_t ws_size, hipStream_t stream) {
    static int grid = 0;
    if (grid == 0) {
        if (n_in != 23 || out_size != ML * 1024 || ws_size < WS_END) { fprintf(stderr, "kernel_launch: unexpected shapes (n_in %d out %d ws %zu need %zu)\n", n_in, out_size, ws_size, (size_t)WS_END); grid = -1; return; }
        int dev = 0, cus = 0, per_cu = 0;
        hipGetDevice(&dev); hipDeviceGetAttribute(&cus, hipDeviceAttributeMultiprocessorCount, dev);
        if (hipFuncSetAttribute((const void*)mk_fwd, hipFuncAttributeMaxDynamicSharedMemorySize, LDS_BYTES) != hipSuccess) { fprintf(stderr, "kernel_launch: hipFuncSetAttribute failed\n"); grid = -1; return; }
        hipOccupancyMaxActiveBlocksPerMultiprocessor(&per_cu, (const void*)mk_fwd, NTHR, LDS_BYTES);
        if (per_cu < 1) { fprintf(stderr, "kernel_launch: occupancy query says %d\n", per_cu); per_cu = 1; }
        grid = cus * 1;
        fprintf(stderr, "kernel_launch: grid %d (cus %d, per_cu %d)\n", grid, cus, per_cu);
    }
    if (grid < 0) return;
    Params p{};
    for (int i = 0; i < 23; ++i) p.in[i] = (const float*)d_in[i];
    p.out = (float*)d_out; p.ws = (unsigned char*)d_ws;
#if MK_MULTI
    for (int s = 0; s < NSTAGE; ++s) { p.st_lo = s; p.st_hi = s + 1; void* args[] = {&p};
        hipError_t e = hipLaunchCooperativeKernel((const void*)mk_fwd, dim3(grid), dim3(NTHR), args, LDS_BYTES, stream);
        if (e != hipSuccess) { fprintf(stderr, "launch %d failed: %s\n", s, hipGetErrorString(e)); break; } }
#else
    p.st_lo = 0; p.st_hi = NSTAGE; void* args[] = {&p};
    hipError_t e = hipLaunchCooperativeKernel((const void*)mk_fwd, dim3(grid), dim3(NTHR), args, LDS_BYTES, stream);
    if (e != hipSuccess) fprintf(stderr, "cooperative launch failed: %s (grid %d)\n", hipGetErrorString(e), grid);
#endif
}
```
